# Optimizing an MI355X kernel written in HIP

```python
import jax
import jax.numpy as jnp
from jax import lax
import numpy as np

D_MODEL = 2048
BATCH = 1
SEQ = 8192
DEPTH = 4

GRID_W = 64
CTX_LEN = 256
N_EVEN = (DEPTH + 1) // 2
N_ODD = DEPTH // 2
D_FF = ((8 * D_MODEL // 3 + 255) // 256) * 256
NORM_EPS = 1e-6
ROPE_THETA = 10000.0
NA_HD = 128
A_W = D_MODEL // 2
NA_HEADS = A_W // NA_HD
NA_ROWS_MAX = 8
NA_COLS = 16
HG_DK = 128
B_W = D_MODEL // 2
HG_HEADS = B_W // HG_DK
HG_CHUNK = 64
C_HD = 128
C_HEADS = D_MODEL // C_HD
C_KV_HEADS = C_HEADS // 4
C_GROUP = C_HEADS // C_KV_HEADS
C_WINDOW = 128
C_BLOCK = 128
C_QKV = (C_HEADS + 2 * C_KV_HEADS) * C_HD
EVEN_IN = 3 * A_W + 5 * B_W
EVEN_SPLITS = (A_W, 2 * A_W, 3 * A_W, 3 * A_W + B_W, 3 * A_W + 2 * B_W, 3 * A_W + 3 * B_W, 3 * A_W + 4 * B_W)
C_SPLITS = (C_HEADS * C_HD, (C_HEADS + C_KV_HEADS) * C_HD)

kernel_name = 'hybrid_na_hgrn2_swa_diffusion_trunk'


def rms_norm(x, g):
    x32 = x.astype(jnp.float32)
    y = x32 * lax.rsqrt(jnp.mean(x32 * x32, axis=-1, keepdims=True) + NORM_EPS)
    return (y * g.astype(jnp.float32)).astype(x.dtype)


def adaln(x, g, shift, scale):
    return rms_norm(x, g) * (1 + scale) + shift


def swiglu(u, w_in, w_out):
    gate, up = jnp.split(u @ w_in, 2, axis=-1)
    return (jax.nn.silu(gate) * up) @ w_out


def rope_1d(x, pos):
    d = x.shape[-1]
    inv = ROPE_THETA ** (-jnp.arange(0, d, 2, dtype=jnp.float32) / d)
    ang = pos.astype(jnp.float32)[:, None] * inv[None, :]
    cos = jnp.cos(ang)[None, :, None, :].astype(x.dtype)
    sin = jnp.sin(ang)[None, :, None, :].astype(x.dtype)
    x1, x2 = jnp.split(x, 2, axis=-1)
    return jnp.concatenate([x1 * cos - x2 * sin, x1 * sin + x2 * cos], axis=-1)


def axial_rope(x, rows, cols):
    xr, xc = jnp.split(x, 2, axis=-1)
    return jnp.concatenate([rope_1d(xr, rows), rope_1d(xc, cols)], axis=-1)


def context_attention(q, k, v, sink=None):
    bsz, seq, kvh, grp, hd = q.shape
    s = jnp.einsum('blkgd,bmkd->bkglm', q, k).astype(jnp.float32) * (hd ** -0.5)
    if sink is not None:
        s_sink = jnp.broadcast_to(sink.astype(jnp.float32).reshape(1, kvh, grp, 1, 1), s.shape[:-1] + (1,))
        p = jax.nn.softmax(jnp.concatenate([s, s_sink], axis=-1), axis=-1)[..., :-1]
    else:
        p = jax.nn.softmax(s, axis=-1)
    o = jnp.einsum('bkglm,bmkd->blkgd', p.astype(v.dtype), v)
    return o.reshape(bsz, seq, kvh * grp * hd)


def neighbourhood_attention(q, k, v, kc, vc, rpb):
    bsz, n, nh, hd = q.shape
    rows = n // GRID_W
    kr = min(NA_ROWS_MAX, rows)
    scale = hd ** -0.5
    kg = k.reshape(bsz, rows, GRID_W, nh, hd)
    vg = v.reshape(bsz, rows, GRID_W, nh, hd)
    q_rows = jnp.moveaxis(q.reshape(bsz, rows, GRID_W, nh, hd), 1, 0)
    col = jnp.arange(GRID_W)
    col_idx = jnp.clip(col - NA_COLS // 2, 0, GRID_W - NA_COLS)[:, None] + jnp.arange(NA_COLS)[None, :]
    rpb_cols = rpb[:, :, col_idx - col[:, None] + NA_COLS - 1]
    n_loc = kr * NA_COLS

    def one_row(args):
        q_r, r = args
        r0 = jnp.clip(r - kr // 2, 0, rows - kr)
        k_win = lax.dynamic_slice_in_dim(kg, r0, kr, axis=1)[:, :, col_idx]
        v_win = lax.dynamic_slice_in_dim(vg, r0, kr, axis=1)[:, :, col_idx]
        row_bias_idx = r0 + jnp.arange(kr) - r + NA_ROWS_MAX - 1
        bias = jnp.transpose(rpb_cols[:, row_bias_idx], (0, 2, 1, 3)).astype(jnp.float32)
        s_loc = jnp.einsum('bqhd,bkqjhd->bhqkj', q_r, k_win).astype(jnp.float32) * scale + bias[None]
        s_ctx = jnp.einsum('bqhd,blhd->bhql', q_r, kc).astype(jnp.float32) * scale
        s = jnp.concatenate([s_loc.reshape(bsz, nh, GRID_W, n_loc), s_ctx], axis=-1)
        p = jax.nn.softmax(s, axis=-1).astype(v.dtype)
        p_loc = p[..., :n_loc].reshape(bsz, nh, GRID_W, kr, NA_COLS)
        return (jnp.einsum('bhqkj,bkqjhd->bqhd', p_loc, v_win)
                + jnp.einsum('bhql,blhd->bqhd', p[..., n_loc:], vc))

    out = lax.map(one_row, (q_rows, jnp.arange(rows)))
    return jnp.moveaxis(out, 0, 1).reshape(bsz, n, nh * hd)


def hgrn_gates(fx, lb):
    fx32 = fx.astype(jnp.float32)
    lb = lb.reshape(HG_HEADS, HG_DK)
    log_f = jnp.logaddexp(jnp.log(lb), jnp.log1p(-lb) + jax.nn.log_sigmoid(fx32))
    k = (1.0 - lb) * jax.nn.sigmoid(-fx32)
    return log_f, k


def gated_chunk_scan(q, k, v, log_f, s0, with_out):
    bsz, t_len, nh, _ = k.shape
    nc = t_len // HG_CHUNK

    def chunks(t):
        return jnp.transpose(t.astype(jnp.float32).reshape(bsz, nc, HG_CHUNK, nh, t.shape[-1]), (1, 0, 3, 2, 4))

    tri = jnp.tril(jnp.ones((HG_CHUNK, HG_CHUNK), dtype=bool))

    def step(state, inp):
        kc, vc, gc = inp[:3]
        b = jnp.cumsum(gc, axis=2)
        b_last = b[:, :, -1:, :]
        new_state = (jnp.exp(b_last[:, :, 0, :])[..., None] * state
                     + jnp.einsum('bhcd,bhce->bhde', kc * jnp.exp(b_last - b), vc))
        if not with_out:
            return new_state, None
        qc = inp[3]
        o_inter = jnp.einsum('bhcd,bhde->bhce', qc * jnp.exp(b), state)
        diff = b[:, :, :, None, :] - b[:, :, None, :, :]
        decay = jnp.exp(jnp.where(tri[None, None, :, :, None], diff, -jnp.inf))
        attn = jnp.einsum('bhtsd,bhtd->bhts', decay * kc[:, :, None, :, :], qc)
        return new_state, o_inter + jnp.einsum('bhts,bhse->bhte', attn, vc)

    xs = (chunks(k), chunks(v), chunks(log_f)) + ((chunks(q),) if with_out else ())
    s_fin, o = lax.scan(step, s0, xs)
    if with_out:
        o = jnp.transpose(o, (1, 0, 3, 2, 4)).reshape(bsz, t_len, nh, -1)
    return s_fin, o


def hgrn_output(o, g, norm_g):
    bsz, t_len = o.shape[:2]
    o = o * lax.rsqrt(jnp.mean(o * o, axis=-1, keepdims=True) + NORM_EPS)
    o = o.reshape(bsz, t_len, -1) * norm_g.astype(jnp.float32)
    return (o * jax.nn.silu(g.astype(jnp.float32))).astype(g.dtype)


def hgrn2_bidirectional(lat, ctx_in, lb, norm_g, need_ctx):
    def heads(t):
        return t.reshape(t.shape[0], t.shape[1], HG_HEADS, HG_DK)
    q, f_fw, f_bw, i, g = lat
    qc, fc_fw, fc_bw, ic, gc = ctx_in
    qh, ih, qch, ich = heads(q), heads(i), heads(qc), heads(ic)
    bsz = q.shape[0]
    o_lat = 0.0
    o_ctx = 0.0
    for d, (f_l, f_c) in enumerate(((f_fw, fc_fw), (f_bw, fc_bw))):
        rev = (lambda t: t) if d == 0 else (lambda t: jnp.flip(t, axis=1))
        log_f, k = hgrn_gates(heads(f_l), lb[d])
        log_fc, kc = hgrn_gates(heads(f_c), lb[d])
        s0 = jnp.zeros((bsz, HG_HEADS, HG_DK, HG_DK), jnp.float32)
        s_ctx, oc_d = gated_chunk_scan(rev(qch), rev(kc), rev(ich), rev(log_fc), s0, need_ctx)
        _, o_d = gated_chunk_scan(rev(qh), rev(k), rev(ih), rev(log_f), s_ctx, True)
        o_lat = o_lat + rev(o_d)
        if need_ctx:
            o_ctx = o_ctx + rev(oc_d)
    y = hgrn_output(o_lat, g, norm_g)
    yc = hgrn_output(o_ctx, gc, norm_g) if need_ctx else None
    return y, yc


def parallel_na_hgrn(u, uc, w_in, w_out, rpb, lb, hg_norm_g, need_ctx):
    qa, ka, va, *lat_b = jnp.split(u @ w_in, EVEN_SPLITS, axis=-1)
    qa_c, ka_c, va_c, *ctx_b = jnp.split(uc @ w_in, EVEN_SPLITS, axis=-1)

    def heads(t):
        return t.reshape(t.shape[0], t.shape[1], NA_HEADS, NA_HD)
    ya = neighbourhood_attention(heads(qa), heads(ka), heads(va), heads(ka_c), heads(va_c), rpb)
    yb, yb_c = hgrn2_bidirectional(tuple(lat_b), tuple(ctx_b), lb, hg_norm_g, need_ctx)
    y = jnp.concatenate([ya, yb], axis=-1) @ w_out
    if not need_ctx:
        return y, None
    ya_c = context_attention(heads(qa_c)[:, :, :, None, :], heads(ka_c), heads(va_c))
    return y, jnp.concatenate([ya_c, yb_c], axis=-1) @ w_out


def banded_window_attention(q, k, v, kc, vc, sink):
    bsz, n, kvh, grp, hd = q.shape
    nb = n // C_BLOCK
    scale = hd ** -0.5
    qb = q.reshape(bsz, nb, C_BLOCK, kvh, grp, hd)

    def band(t):
        tp = jnp.pad(t, ((0, 0), (C_BLOCK, C_BLOCK), (0, 0), (0, 0))).reshape(bsz, nb + 2, C_BLOCK, kvh, hd)
        return jnp.concatenate([tp[:, :-2], tp[:, 1:-1], tp[:, 2:]], axis=2)

    kb, vb = band(k), band(v)
    blk = jnp.arange(nb)[:, None] * C_BLOCK
    qpos = blk + jnp.arange(C_BLOCK)[None, :]
    kpos = blk - C_BLOCK + jnp.arange(3 * C_BLOCK)[None, :]
    rel = kpos[:, None, :] - qpos[:, :, None]
    valid = (jnp.abs(rel) <= C_WINDOW) & (kpos[:, None, :] >= 0) & (kpos[:, None, :] < n)
    s_loc = jnp.einsum('bnqkgd,bnskd->bnkgqs', qb, kb).astype(jnp.float32) * scale
    s_loc = jnp.where(valid[None, :, None, None], s_loc, -jnp.inf)
    s_ctx = jnp.einsum('bnqkgd,blkd->bnkgql', qb, kc).astype(jnp.float32) * scale
    s_sink = jnp.broadcast_to(sink.astype(jnp.float32).reshape(1, 1, kvh, grp, 1, 1), s_loc.shape[:-1] + (1,))
    p = jax.nn.softmax(jnp.concatenate([s_loc, s_ctx, s_sink], axis=-1), axis=-1).astype(v.dtype)
    n_loc = 3 * C_BLOCK
    n_ctx = kc.shape[1]
    o = (jnp.einsum('bnkgqs,bnskd->bnqkgd', p[..., :n_loc], vb)
         + jnp.einsum('bnkgql,blkd->bnqkgd', p[..., n_loc:n_loc + n_ctx], vc))
    return o.reshape(bsz, n, kvh * grp * hd)


def windowed_gqa_sink(u, uc, w_qkv, w_o, sink, need_ctx):
    bsz, n, _ = u.shape
    n_ctx = uc.shape[1]
    q, k, v = jnp.split(u @ w_qkv, C_SPLITS, axis=-1)
    qc, kc, vc = jnp.split(uc @ w_qkv, C_SPLITS, axis=-1)
    t = jnp.arange(n)
    rows, cols = t // GRID_W, t % GRID_W
    q = axial_rope(q.reshape(bsz, n, C_HEADS, C_HD), rows, cols).reshape(bsz, n, C_KV_HEADS, C_GROUP, C_HD)
    k = axial_rope(k.reshape(bsz, n, C_KV_HEADS, C_HD), rows, cols)
    v = v.reshape(bsz, n, C_KV_HEADS, C_HD)
    kc = kc.reshape(bsz, n_ctx, C_KV_HEADS, C_HD)
    vc = vc.reshape(bsz, n_ctx, C_KV_HEADS, C_HD)
    y = banded_window_attention(q, k, v, kc, vc, sink) @ w_o
    if not need_ctx:
        return y, None
    yc = context_attention(qc.reshape(bsz, n_ctx, C_KV_HEADS, C_GROUP, C_HD), kc, vc, sink) @ w_o
    return y, yc


def setup_inputs(seed: int = 0) -> dict:
    key = jax.random.key(seed)
    ks = jax.random.split(key, 18)

    def nrm(k, shape, s):
        return jax.random.normal(k, shape, jnp.float32) * s

    return {
        'x': nrm(ks[0], (BATCH, SEQ, D_MODEL), 1.0),
        'c': nrm(ks[1], (BATCH, D_MODEL), 1.0),
        'ctx': nrm(ks[2], (BATCH, CTX_LEN, D_MODEL), 1.0),
        'c_ctx': nrm(ks[3], (D_MODEL,), 1.0),
        'w_mod': nrm(ks[4], (DEPTH, D_MODEL, 9 * D_MODEL), 0.5 * D_MODEL ** -0.5),
        'b_mod': nrm(ks[5], (DEPTH, 9 * D_MODEL), 0.02),
        'norm_g': 1.0 + nrm(ks[6], (DEPTH, 3, D_MODEL), 0.05),
        'w_ff_in': nrm(ks[7], (DEPTH, 2, D_MODEL, 2 * D_FF), D_MODEL ** -0.5),
        'w_ff_out': nrm(ks[8], (DEPTH, 2, D_FF, D_MODEL), D_FF ** -0.5),
        'w_in_even': nrm(ks[9], (N_EVEN, D_MODEL, EVEN_IN), D_MODEL ** -0.5),
        'w_out_even': nrm(ks[10], (N_EVEN, A_W + B_W, D_MODEL), (A_W + B_W) ** -0.5),
        'na_rpb': nrm(ks[11], (N_EVEN, NA_HEADS, 2 * NA_ROWS_MAX - 1, 2 * NA_COLS - 1), 0.1),
        'hg_lb_logits': nrm(ks[12], (2, N_EVEN, B_W), 1.0),
        'hg_norm_g': 1.0 + nrm(ks[13], (N_EVEN, B_W), 0.05),
        'w_qkv_odd': nrm(ks[14], (N_ODD, D_MODEL, C_QKV), D_MODEL ** -0.5),
        'w_o_odd': nrm(ks[15], (N_ODD, C_HEADS * C_HD, D_MODEL), (C_HEADS * C_HD) ** -0.5),
        'sink_odd': nrm(ks[16], (N_ODD, C_HEADS), 0.5),
        'final_norm_g': 1.0 + nrm(ks[17], (D_MODEL,), 0.05),
    }


def reference(x, c, ctx, c_ctx, w_mod, b_mod, norm_g, w_ff_in, w_ff_out, w_in_even, w_out_even,
              na_rpb, hg_lb_logits, hg_norm_g, w_qkv_odd, w_o_odd, sink_odd, final_norm_g):
    bsz = x.shape[0]
    h, hc = x, ctx
    lb_all = jnp.cumsum(jax.nn.softmax(hg_lb_logits.astype(jnp.float32), axis=1), axis=1)
    lb_all = lb_all - lb_all[:, :1]
    sc = jax.nn.silu(c)
    scc = jax.nn.silu(c_ctx)
    for l in range(DEPTH):
        need_ctx = l < DEPTH - 1
        mod = (sc @ w_mod[l] + b_mod[l]).reshape(bsz, 3, 3, D_MODEL)[:, :, :, None, :]
        modc = (scc @ w_mod[l] + b_mod[l]).reshape(3, 3, D_MODEL)
        h = h + 0.5 * mod[:, 0, 2] * swiglu(adaln(h, norm_g[l, 0], mod[:, 0, 0], mod[:, 0, 1]), w_ff_in[l, 0], w_ff_out[l, 0])
        hc = hc + 0.5 * modc[0, 2] * swiglu(adaln(hc, norm_g[l, 0], modc[0, 0], modc[0, 1]), w_ff_in[l, 0], w_ff_out[l, 0])
        u = adaln(h, norm_g[l, 1], mod[:, 1, 0], mod[:, 1, 1])
        uc = adaln(hc, norm_g[l, 1], modc[1, 0], modc[1, 1])
        if l % 2 == 0:
            e = l // 2
            y, yc = parallel_na_hgrn(u, uc, w_in_even[e], w_out_even[e], na_rpb[e], lb_all[:, e], hg_norm_g[e], need_ctx)
        else:
            o = l // 2
            y, yc = windowed_gqa_sink(u, uc, w_qkv_odd[o], w_o_odd[o], sink_odd[o], need_ctx)
        h = h + mod[:, 1, 2] * y
        h = h + 0.5 * mod[:, 2, 2] * swiglu(adaln(h, norm_g[l, 2], mod[:, 2, 0], mod[:, 2, 1]), w_ff_in[l, 1], w_ff_out[l, 1])
        if need_ctx:
            hc = hc + modc[1, 2] * yc
            hc = hc + 0.5 * modc[2, 2] * swiglu(adaln(hc, norm_g[l, 2], modc[2, 0], modc[2, 1]), w_ff_in[l, 1], w_ff_out[l, 1])
    return rms_norm(h, final_norm_g)
```

```cpp
#include <hip/hip_runtime.h>
#include <cstdio>
#include <cstdint>

#ifndef N_LAUNCH_MODE
#define N_LAUNCH_MODE 0
#endif
#ifndef NAIVE_GEMM
#define NAIVE_GEMM 0
#endif

#define LAS __attribute__((address_space(3)))
typedef _Float16 half_t;
typedef _Float16 h2 __attribute__((ext_vector_type(2)));
typedef _Float16 h4 __attribute__((ext_vector_type(4)));
typedef _Float16 h8 __attribute__((ext_vector_type(8)));
typedef float f32x2 __attribute__((ext_vector_type(2)));
typedef float f32x4 __attribute__((ext_vector_type(4)));
typedef float f32x16 __attribute__((ext_vector_type(16)));
typedef unsigned u32x4 __attribute__((ext_vector_type(4)));

constexpr int D = 2048, SEQ = 8192, NCTX = 256, MR = SEQ + NCTX, DFF = 5632, NFFIN = 2 * DFF, NEV = 8192, NQKV = 3072, DEPTH = 4;
constexpr int MODN = 9 * D;
constexpr float EPS = 1e-6f;
constexpr float LOG2E = 1.4426950408889634f;
constexpr float QSCALE = 0.08838834764831845f * 1.4426950408889634f;
constexpr int NWAVES = 8, NTHREADS = 512;
constexpr int LDS_BYTES = 147456;

constexpr size_t al256(size_t x) { return (x + 255) & ~(size_t)255; }
constexpr size_t WS_BAR = 0;
constexpr size_t WS_ZERO_END = 16384;
constexpr size_t WS_MOD = 16384;
constexpr size_t WS_LB = al256(WS_MOD + (size_t)DEPTH * 2 * MODN * 4);
constexpr size_t WS_ROPE = WS_LB + 2 * 2 * 1024 * 4;
constexpr size_t WS_H = al256(WS_ROPE + 2 * 128 * 32 * 4);
constexpr size_t WS_U = WS_H + (size_t)MR * D * 2;
constexpr size_t WS_HID = WS_U + (size_t)MR * D * 2;
constexpr size_t WS_Y = WS_HID + (size_t)MR * DFF * 2;
constexpr size_t WS_P0 = WS_Y + (size_t)MR * D * 2;
constexpr size_t WS_QA = WS_P0;
constexpr size_t WS_KA = WS_QA + (size_t)MR * 1024 * 2;
constexpr size_t WS_VTA = WS_KA + (size_t)MR * 1024 * 2;
constexpr size_t WS_QB = WS_VTA + (size_t)MR * 1024 * 2;
constexpr size_t WS_LF = WS_QB + (size_t)MR * 1024 * 2;
constexpr size_t WS_VTB = WS_LF + (size_t)2 * MR * 1024 * 2;
constexpr size_t WS_GS = WS_VTB + (size_t)MR * 1024 * 2;
constexpr size_t WS_KH = WS_GS + (size_t)MR * 1024 * 2;
constexpr size_t WS_PE_END = WS_KH + (size_t)2 * MR * 1024 * 2;
constexpr size_t WS_Q = WS_P0;
constexpr size_t WS_K = WS_Q + (size_t)MR * 2048 * 2;
constexpr size_t WS_VT = WS_K + (size_t)MR * 512 * 2;
constexpr size_t WS_VROW = WS_PE_END;
constexpr size_t WS_OG = WS_VROW + (size_t)MR * 1024 * 2;
constexpr size_t WS_US = WS_OG + (size_t)2 * MR * 1024 * 4;
constexpr size_t WS_DEC = WS_US + (size_t)2 * 132 * 8 * 128 * 128 * 2;
constexpr size_t WS_PART = al256(WS_DEC + (size_t)2 * 132 * 8 * 128 * 4);
constexpr size_t WS_W = WS_PART + (size_t)22 * 256 * 2048 * 4;
constexpr size_t WS_WFI = WS_W;
constexpr size_t WS_WFO = WS_WFI + (size_t)8 * NFFIN * D * 2;
constexpr size_t WS_WIE = WS_WFO + (size_t)8 * D * DFF * 2;
constexpr size_t WS_WOE = WS_WIE + (size_t)2 * NEV * D * 2;
constexpr size_t WS_WQKV = WS_WOE + (size_t)2 * D * D * 2;
constexpr size_t WS_WOO = WS_WQKV + (size_t)2 * NQKV * D * 2;
constexpr size_t WS_MODPART = WS_WOO + (size_t)2 * D * D * 2;
constexpr size_t WS_END = WS_MODPART + (size_t)DEPTH * 32 * 2 * MODN * 4;

#define XB_TMO      128
#define XB_XCNT(j)  (256  + 64 * (j))
#define XB_XSUB(j)  (1280 + 64 * (j))
#define XB_XGEN(j)  (2304 + 64 * (j))
#define XB_TOP      3328
#define XB_TOPGEN   3392
#define XCD_BAR_WORDS 3456
#define XB_SPIN_CAP (1u << 22)
__device__ __forceinline__ unsigned xb_ld(unsigned* p)              { return __hip_atomic_load(p, __ATOMIC_RELAXED, __HIP_MEMORY_SCOPE_AGENT); }
__device__ __forceinline__ unsigned xb_add(unsigned* p, unsigned v) { return __hip_atomic_fetch_add(p, v, __ATOMIC_RELAXED, __HIP_MEMORY_SCOPE_AGENT); }
__device__ __forceinline__ unsigned xb_xcc_id() { return (unsigned)__builtin_amdgcn_s_getreg((3 << 11) | 20) & 0xFu; }
#define XB_SPIN(cond, bar) do { unsigned _sp = 0; while (cond) { __builtin_amdgcn_s_sleep(1); \
    if ((++_sp & 255u) == 0u) { if (xb_ld(&(bar)[XB_TMO])) break; if (_sp > XB_SPIN_CAP) { atomicAdd(&(bar)[XB_TMO], 1u); break; } } } } while (0)
struct XcdBarrier { unsigned* bar; unsigned x; volatile LAS unsigned* st; };
__device__ __forceinline__ XcdBarrier xcd_barrier_post(unsigned* bar, volatile LAS unsigned* st) {
    XcdBarrier b; b.bar = bar; b.x = xb_xcc_id(); b.st = st;
    if (threadIdx.x == 0) (void)xb_add(&bar[XB_XCNT(b.x)], 1u);
    return b;
}
__device__ __forceinline__ void xcd_barrier_complete(unsigned* bar, unsigned x, unsigned& nloc, unsigned& nx) {
    const unsigned G = gridDim.x * gridDim.y * gridDim.z;
    unsigned sum, cnt, mine, sp = 0u;
    for (;;) {
        sum = 0u; cnt = 0u; mine = 0u;
#pragma unroll
        for (unsigned j = 0; j < 16; ++j) { const unsigned c = xb_ld(&bar[XB_XCNT(j)]); sum += c; cnt += (c > 0u) ? 1u : 0u; mine = (j == x) ? c : mine; }
        if (sum == G) break;
        __builtin_amdgcn_s_sleep(1);
        if ((++sp & 255u) == 0u) { if (xb_ld(&bar[XB_TMO])) break; if (sp > XB_SPIN_CAP) { atomicAdd(&bar[XB_TMO], 1u); break; } }
    }
    nloc = mine > 0u ? mine : 1u; nx = cnt > 0u ? cnt : 1u;
}
__device__ __forceinline__ void xcd_barrier(const XcdBarrier& b) {
    asm volatile("s_waitcnt vmcnt(0)" ::: "memory");
    __syncthreads();
    if (threadIdx.x == 0) {
        unsigned* bar = b.bar;
        __builtin_amdgcn_s_waitcnt(0);
        unsigned nloc = b.st[0], nx = b.st[1];
        if (nloc == 0u) { xcd_barrier_complete(bar, b.x, nloc, nx); b.st[0] = nloc; b.st[1] = nx; }
        const unsigned old = xb_add(&bar[XB_XSUB(b.x)], 1u);
        const unsigned gen = old / nloc;
        if (old + 1u == (gen + 1u) * nloc) {
            __builtin_amdgcn_fence(__ATOMIC_RELEASE, "agent");
            asm volatile("s_waitcnt vmcnt(0)" ::: "memory");
            const unsigned og = xb_add(&bar[XB_TOP], 1u);
            const unsigned tg = og / nx;
            if (og + 1u == (tg + 1u) * nx) xb_add(&bar[XB_TOPGEN], 1u);
            else XB_SPIN(xb_ld(&bar[XB_TOPGEN]) == tg, bar);
            __builtin_amdgcn_fence(__ATOMIC_ACQUIRE, "agent");
            xb_add(&bar[XB_XGEN(b.x)], 1u);
            asm volatile("s_waitcnt vmcnt(0)" ::: "memory");
        } else {
            XB_SPIN(xb_ld(&bar[XB_XGEN(b.x)]) == gen, bar);
            __builtin_amdgcn_fence(__ATOMIC_ACQUIRE, "agent");
            asm volatile("s_waitcnt vmcnt(0)" ::: "memory");
        }
    }
    __syncthreads();
}

__device__ __forceinline__ float wave_sum(float v) {
#pragma unroll
    for (int o = 32; o >= 1; o >>= 1) v += __shfl_xor(v, o);
    return v;
}
__device__ __forceinline__ float wave_max(float v) {
#pragma unroll
    for (int o = 32; o >= 1; o >>= 1) v = fmaxf(v, __shfl_xor(v, o));
    return v;
}
__device__ __forceinline__ float fast_exp2(float x) { return __builtin_amdgcn_exp2f(x); }
__device__ __forceinline__ float silu_f(float g) { return g * __builtin_amdgcn_rcpf(1.0f + fast_exp2(-g * LOG2E)); }
__device__ __forceinline__ h8 pack8(const f32x4 a, const f32x4 b) {
    h8 o; o[0] = (half_t)a[0]; o[1] = (half_t)a[1]; o[2] = (half_t)a[2]; o[3] = (half_t)a[3]; o[4] = (half_t)b[0]; o[5] = (half_t)b[1]; o[6] = (half_t)b[2]; o[7] = (half_t)b[3]; return o;
}

#ifndef DROP_FFN
#define DROP_FFN 4
#endif
#ifndef DROP_MIX
#define DROP_MIX 3
#endif
typedef unsigned u32x2 __attribute__((ext_vector_type(2)));
__host__ __device__ constexpr unsigned opr_add(int drop) { return ((1u << drop) >> 1) * 0x00010001u; }
__host__ __device__ constexpr unsigned opr_mask(int drop) { return ~(((1u << drop) - 1u) * 0x00010001u); }
__device__ __forceinline__ h8 opround(const h8 v, int drop) { u32x4 u = __builtin_bit_cast(u32x4, v); u = (u + opr_add(drop)) & opr_mask(drop); return __builtin_bit_cast(h8, u); }
__device__ __forceinline__ h4 opround(const h4 v, int drop) { u32x2 u = __builtin_bit_cast(u32x2, v); u = (u + opr_add(drop)) & opr_mask(drop); return __builtin_bit_cast(h4, u); }

struct Frame {
    LAS unsigned char* lds; int tid, lane, wave, G, bid;
    const float* in[18]; float* out; unsigned char* ws;
};

namespace pg8 {
constexpr int BM = 256, BK = 64, HALF = 128, HTB = HALF * BK * 2, STAGE_BYTES = 8 * HTB, NXCD = 8, WGM = 8;
__host__ __device__ __forceinline__ int lds_byte(int r, int c) { const int st = (r >> 4) * 2 + (c >> 5), rr = r & 15, cc = c & 31, ob = rr * 64 + cc * 2; return st * 1024 + (ob ^ (((ob >> 9) & 1) << 5)); }
__host__ __device__ __forceinline__ void stage_rc(int b, int& R, int& C) { const int st = b / 1024, sb = b % 1024, swz = sb ^ (((sb >> 9) & 1) << 5); R = (st >> 1) * 16 + swz / 64; C = (st & 1) * 32 + (swz % 64) / 2; }
__host__ __device__ __forceinline__ int perm32(int rho) { const int n = rho >> 4, i = rho & 15; return 8 * (i >> 2) + 4 * n + (i & 3); }
struct Unit { int pm, pn, kt0, nkt, part; };
struct Gemm { const half_t* A; const half_t* Bt; int M, N, K; };
struct StaticOrder {
    int nM, nN, nwg, G, c, nkt, slice_kt, nslu;
    __host__ __device__ __forceinline__ void init(int M, int N, int K, int G_, int c_, int slice_kt_ = 0) { nM = M / BM; nN = N / BM; nwg = nM * nN; G = G_; c = c_; nkt = K / BK; slice_kt = slice_kt_; nslu = slice_kt_ ? (nkt / slice_kt_) * nN : 0; }
    __host__ __device__ __forceinline__ bool next(int i, Unit& u) const {
        const int L = i * G + c, j = L - nwg; const bool mainu = L < nwg;
        if (!mainu && j >= nslu) return false;
        int wgid = mainu ? L : 0; { const int q = nwg / NXCD, r = nwg % NXCD, xcd = wgid % NXCD, off = wgid / NXCD; wgid = (xcd < r ? xcd * (q + 1) : r * (q + 1) + (xcd - r) * q) + off; }
        const int nig = WGM * nN, gid = wgid / nig, fm = gid * WGM, gsz = (nM - fm) < WGM ? (nM - fm) : WGM;
        const int pm_m = fm + ((wgid % nig) % gsz), pn_m = (wgid % nig) / gsz, jj = mainu ? 0 : j, ks = jj / nN;
        u.pm = mainu ? pm_m : SEQ / BM; u.pn = mainu ? pn_m : jj - ks * nN; u.part = mainu ? 0 : 1 + ks; u.kt0 = mainu ? 0 : ks * slice_kt; u.nkt = mainu ? nkt : slice_kt;
        return true;
    }
};
#if !NAIVE_GEMM
template <class Epi, class Sched>
__device__ __forceinline__ void gemm_phase(LAS unsigned char* lds, const Gemm g, const Sched& S, const Epi& E) {
    int tid = threadIdx.x; asm volatile("" : "+v"(tid));
    const int wid = __builtin_amdgcn_readfirstlane(tid >> 6), lane = tid & 63, wr = wid >> 2, wc = wid & 3, fr = lane & 15, fq = lane >> 4;
    const int K = g.K;
    unsigned voffA[2], voffB[2];
#pragma unroll
    for (int i = 0; i < 2; ++i) { int R, C; stage_rc(tid * 16 + i * 8192, R, C); const int Rb = (R & ~31) + perm32(R & 31);
        voffA[i] = (unsigned)(R * K + C) * 2u; voffB[i] = (unsigned)(Rb * K + C) * 2u; }
    const size_t kstep = (size_t)(BK * 2);
    const size_t hstep = (size_t)HALF * K * 2;
    const size_t tstep = 2 * hstep;
    const unsigned ldsw = (unsigned)wid * 1024u;
    const int aoff = lds_byte(wr * 64 + fr, fq * 8), boff = lds_byte(wc * 32 + fr, fq * 8);
#define PG8_SA(b, h) (((b) * 2 + (h)) * HTB)
#define PG8_SB(b, h) ((4 + (b) * 2 + (h)) * HTB)
#define PG8_STAGE(bufoff, gbase, voff) do { _Pragma("unroll") for (int _i = 0; _i < 2; ++_i) \
        __builtin_amdgcn_global_load_lds((const unsigned*)((const char*)(gbase) + (voff)[_i]), (LAS unsigned*)(lds + (bufoff) + ldsw + _i * 8192), 16, 0, 0); } while (0)
#define PG8_LDA(dst, b, h) do { _Pragma("unroll") for (int m = 0; m < 4; ++m) _Pragma("unroll") for (int k = 0; k < 2; ++k) dst[m][k] = *(const LAS h8*)(lds + PG8_SA(b, h) + aoff + m * 2048 + k * 1024); } while (0)
#define PG8_LDB(dst, b, h) do { _Pragma("unroll") for (int n = 0; n < 2; ++n) _Pragma("unroll") for (int k = 0; k < 2; ++k) dst[n][k] = *(const LAS h8*)(lds + PG8_SB(b, h) + boff + n * 2048 + k * 1024); } while (0)
#define PG8_MMA(ai, bj, At, Bt) do { __builtin_amdgcn_s_setprio(1); _Pragma("unroll") for (int m = 0; m < 4; ++m) _Pragma("unroll") for (int n = 0; n < 2; ++n) _Pragma("unroll") for (int k = 0; k < 2; ++k) \
        acc[ai][bj][m][n] = __builtin_amdgcn_mfma_f32_16x16x32_f16(Bt[n][k], At[m][k], acc[ai][bj][m][n], 0, 0, 0); __builtin_amdgcn_s_setprio(0); } while (0)
#define PG8_WAIT_V(n) asm volatile("s_waitcnt vmcnt(" #n ")" ::: "memory")
#define PG8_WAIT_L(n) asm volatile("s_waitcnt lgkmcnt(" #n ")" ::: "memory")
#define PG8_BAR __builtin_amdgcn_s_barrier()
#define PG8_SCHED __builtin_amdgcn_sched_barrier(0)
    Unit cur, nxt; int ui = 0;
    if (!S.next(0, cur)) return;
    f32x4 acc[2][2][4][2];
#pragma unroll
    for (int a = 0; a < 2; ++a)
#pragma unroll
        for (int b = 0; b < 2; ++b)
#pragma unroll
            for (int m = 0; m < 4; ++m)
#pragma unroll
                for (int n = 0; n < 2; ++n) acc[a][b][m][n] = (f32x4){0.f, 0.f, 0.f, 0.f};
    h8 At[4][2], B0[2][2], B1[2][2];
    const char* cA = (const char*)g.A + (size_t)cur.pm * tstep + (size_t)cur.kt0 * kstep; const char* cB = (const char*)g.Bt + (size_t)cur.pn * tstep + (size_t)cur.kt0 * kstep;
    PG8_STAGE(PG8_SB(0, 0), cB, voffB); PG8_STAGE(PG8_SB(0, 1), cB + hstep, voffB); PG8_STAGE(PG8_SA(0, 0), cA, voffA); PG8_STAGE(PG8_SA(0, 1), cA + hstep, voffA);
    if (wr == 1) PG8_BAR;
    PG8_WAIT_V(2); PG8_BAR;
    PG8_STAGE(PG8_SB(1, 0), cB + kstep, voffB); PG8_STAGE(PG8_SA(1, 0), cA + kstep, voffA); PG8_STAGE(PG8_SB(1, 1), cB + hstep + kstep, voffB);
    PG8_WAIT_V(6); PG8_BAR;
    for (;;) {
        const bool has_next = S.next(ui + 1, nxt);
        const char* nA = has_next ? (const char*)g.A + (size_t)nxt.pm * tstep + (size_t)nxt.kt0 * kstep : cA; const char* nB = has_next ? (const char*)g.Bt + (size_t)nxt.pn * tstep + (size_t)nxt.kt0 * kstep : cB;
        const int nt = cur.nkt;
        for (int t = 0; t < nt; t += 2) {
            const bool last = (t == nt - 2);
            const char* a1 = cA + (size_t)(t + 1) * kstep;
            const char* a2 = last ? nA : cA + (size_t)(t + 2) * kstep; const char* b2 = last ? nB : cB + (size_t)(t + 2) * kstep;
            const char* a3 = a2 + kstep; const char* b3 = b2 + kstep;
            PG8_LDB(B0, 0, 0); PG8_LDB(B1, 0, 1); PG8_SCHED; PG8_LDA(At, 0, 0); PG8_STAGE(PG8_SA(1, 1), a1 + hstep, voffA);
            PG8_WAIT_V(8); PG8_WAIT_L(0); PG8_BAR; PG8_MMA(0, 0, At, B0); PG8_MMA(0, 1, At, B1); PG8_BAR; PG8_SCHED;
            PG8_LDA(At, 0, 1); PG8_STAGE(PG8_SB(0, 0), b2, voffB); PG8_STAGE(PG8_SB(0, 1), b2 + hstep, voffB); PG8_STAGE(PG8_SA(0, 0), a2, voffA);
            PG8_WAIT_V(8); PG8_WAIT_L(0); PG8_BAR; PG8_MMA(1, 0, At, B0); PG8_MMA(1, 1, At, B1); PG8_BAR; PG8_SCHED;
            PG8_LDB(B0, 1, 0); PG8_LDB(B1, 1, 1); PG8_SCHED; PG8_LDA(At, 1, 0); PG8_STAGE(PG8_SA(0, 1), a2 + hstep, voffA);
            PG8_WAIT_V(8); PG8_WAIT_L(0); PG8_BAR; PG8_MMA(0, 0, At, B0); PG8_MMA(0, 1, At, B1); PG8_BAR; PG8_SCHED;
            PG8_LDA(At, 1, 1); PG8_STAGE(PG8_SB(1, 0), b3, voffB); PG8_STAGE(PG8_SB(1, 1), b3 + hstep, voffB); PG8_STAGE(PG8_SA(1, 0), a3, voffA);
            PG8_WAIT_V(8); PG8_WAIT_L(0); PG8_BAR; PG8_MMA(1, 0, At, B0); PG8_MMA(1, 1, At, B1); PG8_BAR; PG8_SCHED;
        }
        if (wr == 0) PG8_BAR;
        E(acc, cur, wr, wc, fr, fq);
        if (!has_next) break;
#pragma unroll
        for (int a = 0; a < 2; ++a)
#pragma unroll
            for (int b = 0; b < 2; ++b)
#pragma unroll
                for (int m = 0; m < 4; ++m)
#pragma unroll
                    for (int n = 0; n < 2; ++n) acc[a][b][m][n] = (f32x4){0.f, 0.f, 0.f, 0.f};
        cur = nxt; cA = nA; cB = nB; ++ui;
        if (wr == 1) PG8_BAR;
    }
    PG8_WAIT_V(0);
    PG8_BAR;
#undef PG8_SA
#undef PG8_SB
#undef PG8_STAGE
#undef PG8_LDA
#undef PG8_LDB
#undef PG8_MMA
#undef PG8_WAIT_V
#undef PG8_WAIT_L
#undef PG8_BAR
#undef PG8_SCHED
}
#else
template <class Epi, class Sched>
__device__ __forceinline__ void gemm_phase(LAS unsigned char* lds, const Gemm g, const Sched& S, const Epi& E) {
    const int tid = threadIdx.x, wid = tid >> 6, lane = tid & 63, wr = wid >> 2, wc = wid & 3, fr = lane & 15, fq = lane >> 4;
    const int K = g.K; Unit u;
    for (int ui = 0; S.next(ui, u); ++ui) {
        f32x4 acc[2][2][4][2];
#pragma unroll
        for (int ai = 0; ai < 2; ++ai)
#pragma unroll
        for (int bj = 0; bj < 2; ++bj)
#pragma unroll
        for (int m = 0; m < 4; ++m)
#pragma unroll
        for (int n = 0; n < 2; ++n) {
            f32x4 s = {0.f, 0.f, 0.f, 0.f};
            const half_t* a = g.A + (size_t)(u.pm * 256 + ai * 128 + wr * 64 + m * 16 + fr) * K;
            const half_t* b = g.Bt + (size_t)(u.pn * 256 + bj * 128 + wc * 32 + fq * 8 + n * 4) * K;
            for (int k = u.kt0 * 64; k < (u.kt0 + u.nkt) * 64; k += 8) { const h8 av = *(const h8*)(a + k);
                for (int r = 0; r < 4; ++r) { const h8 bv = *(const h8*)(b + (size_t)r * K + k); float t = s[r];
                    for (int j = 0; j < 8; ++j) t += (float)av[j] * (float)bv[j];
                    s[r] = t; } }
            acc[ai][bj][m][n] = s; }
        E(acc, u, wr, wc, fr, fq);
    }
}
#endif
}

struct EpiSwiGLU {
    half_t* hid;
    __device__ __forceinline__ void operator()(const f32x4 (&acc)[2][2][4][2], const pg8::Unit& u, int wr, int wc, int fr, int fq) const {
        asm volatile("" : "+v"(fr), "+v"(fq));
        const int row0 = u.pm * 256 + wr * 64 + fr, col0 = u.pn * 128 + wc * 32 + 8 * fq;
#pragma unroll
        for (int ai = 0; ai < 2; ++ai)
#pragma unroll
            for (int m = 0; m < 4; ++m) {
                const f32x4 g0 = acc[ai][0][m][0], g1 = acc[ai][0][m][1], u0 = acc[ai][1][m][0], u1 = acc[ai][1][m][1];
                f32x4 o0, o1;
#pragma unroll
                for (int j = 0; j < 4; ++j) { o0[j] = silu_f(g0[j]) * u0[j]; o1[j] = silu_f(g1[j]) * u1[j]; }
                *(h8*)(hid + (size_t)(row0 + ai * 128 + m * 16) * DFF + col0) = opround(pack8(o0, o1), DROP_FFN);
            }
    }
};
struct EpiResid {
    unsigned char* ws; const float* coef_lat; float scale;
    __device__ __forceinline__ void operator()(const f32x4 (&acc)[2][2][4][2], const pg8::Unit& u, int wr, int wc, int fr, int fq) const {
        asm volatile("" : "+v"(fr), "+v"(fq));
        const int col0 = u.pn * 256 + wc * 32 + 8 * fq;
        const float* coef = coef_lat + ((u.pm == SEQ / 256) ? MODN : 0) + col0;
        const f32x4 c00 = *(const f32x4*)(coef) * scale, c01 = *(const f32x4*)(coef + 4) * scale, c10 = *(const f32x4*)(coef + 128) * scale, c11 = *(const f32x4*)(coef + 132) * scale;
        if (u.part) {
            float* base = (float*)(ws + WS_PART) + (size_t)(u.part - 1) * NCTX * D + (size_t)(wr * 64 + fr) * D + col0;
#pragma unroll
            for (int ai = 0; ai < 2; ++ai)
#pragma unroll
                for (int m = 0; m < 4; ++m) { float* rowp = base + (size_t)(ai * 128 + m * 16) * D;
                    *(f32x4*)(rowp) = c00 * acc[ai][0][m][0]; *(f32x4*)(rowp + 4) = c01 * acc[ai][0][m][1]; *(f32x4*)(rowp + 128) = c10 * acc[ai][1][m][0]; *(f32x4*)(rowp + 132) = c11 * acc[ai][1][m][1]; }
        } else {
            half_t* base = (half_t*)(ws + WS_H) + (size_t)(u.pm * 256 + wr * 64 + fr) * D + col0;
#pragma unroll
            for (int ai = 0; ai < 2; ++ai)
#pragma unroll
                for (int m = 0; m < 4; ++m) { half_t* rowp = base + (size_t)(ai * 128 + m * 16) * D;
                    const h8 h0 = *(const h8*)rowp, h1 = *(const h8*)(rowp + 128); f32x4 v00, v01, v10, v11;
#pragma unroll
                    for (int j = 0; j < 4; ++j) { v00[j] = (float)h0[j]; v01[j] = (float)h0[4 + j]; v10[j] = (float)h1[j]; v11[j] = (float)h1[4 + j]; }
                    v00 += c00 * acc[ai][0][m][0]; v01 += c01 * acc[ai][0][m][1]; v10 += c10 * acc[ai][1][m][0]; v11 += c11 * acc[ai][1][m][1];
                    *(h8*)rowp = pack8(v00, v01); *(h8*)(rowp + 128) = pack8(v10, v11); }
        }
    }
};
__device__ __forceinline__ void forget_gates(float fx, float lb, float& logf_, float& k_) {
    const float e = fast_exp2(-fmaxf(fx, -80.f) * LOG2E), r = __builtin_amdgcn_rcpf(1.0f + e);
    logf_ = __builtin_amdgcn_logf(lb + (1.f - lb) * r) * 0.6931471805599453f;
    k_ = (1.f - lb) * e * r;
}
struct EpiEven {
    half_t *QA, *KA, *VTA, *QB, *VTB, *GS, *KH; half_t* LF; const float* lb; const float* hg_norm_g;
    __device__ __forceinline__ void operator()(const f32x4 (&acc)[2][2][4][2], const pg8::Unit& u, int wr, int wc, int fr, int fq) const {
        asm volatile("" : "+v"(fr), "+v"(fq));
        const int row0 = u.pm * 256 + wr * 64 + fr, type = u.pn >> 2, cb0 = (u.pn & 3) * 256 + wc * 32 + 8 * fq;
#ifndef EV_MASK
#define EV_MASK 15
#endif
        if ((EV_MASK & 1) && (type == 0 || type == 1 || type == 3)) {
            half_t* dst = type == 0 ? QA : (type == 1 ? KA : QB); const float sc = type == 0 ? QSCALE : 1.0f;
#pragma unroll
            for (int ai = 0; ai < 2; ++ai)
#pragma unroll
                for (int m = 0; m < 4; ++m)
#pragma unroll
                    for (int bj = 0; bj < 2; ++bj)
                        *(h8*)(dst + (size_t)(row0 + ai * 128 + m * 16) * 1024 + cb0 + bj * 128) = pack8(acc[ai][bj][m][0] * sc, acc[ai][bj][m][1] * sc);
        } else if ((EV_MASK & 2) && (type == 2 || type == 6)) {
            half_t* dst = type == 2 ? VTA : VTB;
#pragma unroll
            for (int bj = 0; bj < 2; ++bj)
#pragma unroll
                for (int n = 0; n < 2; ++n)
#pragma unroll
                    for (int j = 0; j < 4; ++j) { half_t* cp = dst + (size_t)(cb0 + bj * 128 + 4 * n + j) * MR + row0;
#pragma unroll
                        for (int ai = 0; ai < 2; ++ai)
#pragma unroll
                            for (int m = 0; m < 4; ++m) cp[ai * 128 + m * 16] = (half_t)acc[ai][bj][m][n][j];
                        asm volatile("" ::: "memory"); }
        } else if ((EV_MASK & 4) && (type == 4 || type == 5)) {
            half_t* dst = LF + (size_t)(type - 4) * MR * 1024; half_t* dk_ = KH + (size_t)(type - 4) * MR * 1024; const float* lbv = lb + (type - 4) * 2048;
#pragma unroll
            for (int bj = 0; bj < 2; ++bj) { const f32x4 l0 = *(const f32x4*)(lbv + cb0 + bj * 128), l1 = *(const f32x4*)(lbv + cb0 + bj * 128 + 4);
#pragma unroll
                for (int ai = 0; ai < 2; ++ai)
#pragma unroll
                    for (int m = 0; m < 4; ++m) { f32x4 o0, o1, k0, k1; const f32x4 a0 = acc[ai][bj][m][0], a1 = acc[ai][bj][m][1];
#pragma unroll
                        for (int j = 0; j < 4; ++j) { float lo_, ko_; forget_gates(a0[j], l0[j], lo_, ko_); o0[j] = lo_; k0[j] = ko_; forget_gates(a1[j], l1[j], lo_, ko_); o1[j] = lo_; k1[j] = ko_; }
                        const size_t o = (size_t)(row0 + ai * 128 + m * 16) * 1024 + cb0 + bj * 128;
                        *(h8*)(dst + o) = pack8(o0, o1); (void)dk_; (void)k0; (void)k1; } }
        } else if (EV_MASK & 8) {
#pragma unroll
            for (int bj = 0; bj < 2; ++bj) { const f32x4 g0 = *(const f32x4*)(hg_norm_g + cb0 + bj * 128), g1 = *(const f32x4*)(hg_norm_g + cb0 + bj * 128 + 4);
#pragma unroll
                for (int ai = 0; ai < 2; ++ai)
#pragma unroll
                    for (int m = 0; m < 4; ++m) { f32x4 o0, o1; const f32x4 a0 = acc[ai][bj][m][0], a1 = acc[ai][bj][m][1];
#pragma unroll
                        for (int j = 0; j < 4; ++j) { o0[j] = g0[j] * silu_f(a0[j]); o1[j] = g1[j] * silu_f(a1[j]); }
                        *(h8*)(GS + (size_t)(row0 + ai * 128 + m * 16) * 1024 + cb0 + bj * 128) = pack8(o0, o1); } }
        }
    }
};
struct EpiOdd {
    half_t *Q, *Kc, *VT; const float* ropec; const float* ropes;
    __device__ __forceinline__ void operator()(const f32x4 (&acc)[2][2][4][2], const pg8::Unit& u, int wr, int wc, int fr, int fq) const {
        asm volatile("" : "+v"(fr), "+v"(fq));
        const int row0 = u.pm * 256 + wr * 64 + fr;
        if (u.pn < 10) {
            const bool isq = u.pn < 8; const int a = wc >> 1, p = wc & 1, d1 = 64 * p + 8 * fq;
            const int head = isq ? 2 * u.pn + a : 2 * (u.pn - 8) + a; half_t* dst = isq ? Q : Kc; const int pitch = isq ? 2048 : 512; const float sc = isq ? QSCALE : 1.0f;
            const bool lat = u.pm < SEQ / 256;
#pragma unroll
            for (int ai = 0; ai < 2; ++ai)
#pragma unroll
                for (int m = 0; m < 4; ++m) { const int row = row0 + ai * 128 + m * 16;
                    f32x4 x10 = acc[ai][0][m][0], x11 = acc[ai][0][m][1], x20 = acc[ai][1][m][0], x21 = acc[ai][1][m][1];
                    if (lat) { const int pos = p == 0 ? (row >> 6) : (row & 63);
                        const f32x4 c0 = *(const f32x4*)(ropec + pos * 32 + 8 * fq), c1 = *(const f32x4*)(ropec + pos * 32 + 8 * fq + 4);
                        const f32x4 s0 = *(const f32x4*)(ropes + pos * 32 + 8 * fq), s1 = *(const f32x4*)(ropes + pos * 32 + 8 * fq + 4);
                        const f32x4 y10 = x10 * c0 - x20 * s0, y11 = x11 * c1 - x21 * s1, y20 = x10 * s0 + x20 * c0, y21 = x11 * s1 + x21 * c1;
                        x10 = y10; x11 = y11; x20 = y20; x21 = y21; }
                    half_t* o = dst + (size_t)row * pitch + head * 128 + d1;
                    *(h8*)o = pack8(x10 * sc, x11 * sc); *(h8*)(o + 32) = pack8(x20 * sc, x21 * sc); }
        } else {
            const int cb0 = (u.pn - 10) * 256 + wc * 32 + 8 * fq;
#pragma unroll
            for (int bj = 0; bj < 2; ++bj)
#pragma unroll
                for (int n = 0; n < 2; ++n)
#pragma unroll
                    for (int j = 0; j < 4; ++j) { half_t* cp = VT + (size_t)(cb0 + bj * 128 + 4 * n + j) * MR + row0;
#pragma unroll
                        for (int ai = 0; ai < 2; ++ai)
#pragma unroll
                            for (int m = 0; m < 4; ++m) cp[ai * 128 + m * 16] = (half_t)acc[ai][bj][m][n][j];
                        asm volatile("" ::: "memory"); }
        }
    }
};

template <int PERM> __device__ __forceinline__ int dst_row(int n) {
    if (PERM == 1) {
        return n < DFF ? 256 * (n >> 7) + (n & 127) : 256 * ((n - DFF) >> 7) + 128 + ((n - DFF) & 127);
    } else if (PERM == 2) {
        if (n >= 2560) return n;
        const int T = n >> 8, w = n & 255, a = w >> 7, d = w & 127, p = d >> 6, x = (d >> 5) & 1, j = d & 31;
        return 256 * T + 128 * x + 64 * a + 32 * p + j;
    }
    return n;
}
constexpr int MOD_ROWS = 64, NT_MOD = (D / MOD_ROWS) * (MODN / 256);
constexpr int I_FI = (D / 64) * (NFFIN / 32), I_FO = (DFF / 64) * (D / 32), I_IE = (D / 64) * (NEV / 32), I_DD = (D / 64) * (D / 32), I_QKV = (D / 64) * (NQKV / 32);
constexpr int FILL_CAP_FF = 136, FILL_CAP_IE = 88, FILL_CAP_QKV = 136;
constexpr int LT_E = 2 * I_FI + 2 * I_FO + I_IE + I_DD, LT_O = 2 * I_FI + 2 * I_FO + I_QKV + I_DD, CV_TOTAL = 2 * (LT_E + LT_O);
constexpr int CV_PRO = 15424 + 256;
__host__ __device__ constexpr int cv_layer_begin(int L) { return (L >> 1) * (LT_E + LT_O) + ((L & 1) ? LT_E : 0); }
__host__ __device__ constexpr int slot_cap(int k) { return k == 3 * DEPTH - 2 ? CV_TOTAL - I_FO - (CV_PRO + 7 * 84 * FILL_CAP_FF + 2 * 224 * FILL_CAP_IE + 116 * FILL_CAP_QKV)
    : (k % 3) == 1 ? (((k / 3) & 1) ? 116 * FILL_CAP_QKV : 224 * FILL_CAP_IE) : 84 * FILL_CAP_FF; }
__host__ __device__ constexpr int slot_begin_k(int k) { int b = CV_PRO; for (int j = 0; j < k; ++j) b += slot_cap(j); return b < CV_TOTAL ? b : CV_TOTAL; }
__host__ __device__ constexpr int slot_begin(int L, int s) { return slot_begin_k(3 * L + s); }
__host__ __device__ constexpr int slot_end(int L, int s) { return slot_begin_k(3 * L + s + 1); }
__host__ __device__ constexpr int cv_need(int k) { const int L = k / 3, sl = k % 3, in_ = (L & 1) ? I_QKV : I_IE;
    return cv_layer_begin(L) + (sl == 0 ? I_FI : (sl == 1 ? I_FI + I_FO + in_ : 2 * I_FI + I_FO + in_ + I_DD)); }
__host__ __device__ constexpr bool cv_schedule_ok() { for (int k = 0; k < 3 * DEPTH; ++k) if (slot_begin_k(k) < cv_need(k)) return false; return slot_begin_k(3 * DEPTH) == CV_TOTAL; }
static_assert(cv_schedule_ok(), "conversion schedule: a weight would be converted after the phase that reads it");

static_assert(MOD_ROWS == 64, "one k-row per lane");
__device__ __forceinline__ void setup_task(Frame& F, int L, int t) {
    const int cb = t / (D / MOD_ROWS), kc = t % (D / MOD_ROWS), n0 = cb * 256 + 4 * F.lane; const float* w = F.in[4] + ((size_t)L * D + kc * MOD_ROWS) * MODN + n0;
    const float c0 = F.in[1][kc * MOD_ROWS + F.lane], c1 = F.in[3][kc * MOD_ROWS + F.lane];
    const int s0v = __builtin_bit_cast(int, c0 / (1.f + expf(-c0))), s1v = __builtin_bit_cast(int, c1 / (1.f + expf(-c1)));
    f32x4 a0 = {0.f, 0.f, 0.f, 0.f}, a1 = {0.f, 0.f, 0.f, 0.f};
    for (int k = 0; k < MOD_ROWS; k += 16) { f32x4 wv[16];
#pragma unroll
        for (int j = 0; j < 16; ++j) wv[j] = __builtin_nontemporal_load((const f32x4*)(w + (size_t)(k + j) * MODN));
#pragma unroll
        for (int j = 0; j < 16; ++j) { const float s0 = __builtin_bit_cast(float, __builtin_amdgcn_readlane(s0v, k + j)), s1 = __builtin_bit_cast(float, __builtin_amdgcn_readlane(s1v, k + j)); a0 += wv[j] * s0; a1 += wv[j] * s1; } }
    if (kc == 0) { const f32x4 bb = *(const f32x4*)(F.in[5] + (size_t)L * MODN + n0); a0 += bb; a1 += bb; }
    float* pp = (float*)(F.ws + WS_MODPART) + (((size_t)L * 32 + kc) * 2) * MODN + n0;
    *(f32x4*)pp = a0; *(f32x4*)(pp + MODN) = a1;
}
__device__ __forceinline__ void mod_reduce(Frame& F, int L, int n_begin, int n_end, bool allwaves) {
    if (!allwaves && F.wave != 0) return;
    const int nq = (n_end - n_begin) >> 2, nw = allwaves ? NWAVES : 1;
    const float* pb = (const float*)(F.ws + WS_MODPART) + (size_t)L * 32 * 2 * MODN; float* mb = (float*)(F.ws + WS_MOD) + (size_t)L * 2 * MODN;
    for (int gi = (F.bid * nw + (allwaves ? F.wave : 0)) * 64 + F.lane; gi < 2 * nq; gi += F.G * nw * 64) {
        const int v = gi / nq, n = n_begin + 4 * (gi - v * nq); const float* p = pb + (size_t)v * MODN + n;
        f32x4 acc = {0.f, 0.f, 0.f, 0.f};
        for (int k0 = 0; k0 < 32; k0 += 16) { f32x4 x[16];
#pragma unroll
            for (int k = 0; k < 16; ++k) x[k] = *(const f32x4*)(p + (size_t)(k0 + k) * 2 * MODN);
#pragma unroll
            for (int k = 0; k < 16; ++k) acc += x[k]; }
        *(f32x4*)(mb + (size_t)v * MODN + n) = acc;
    }
}
struct ConvDesc { const float* W; half_t* Wt; int K, N, perm, k0, n0; };
__device__ __forceinline__ ConvDesc conv_decode(Frame& F, int g) {
    unsigned char* ws = F.ws; const int L = (g >= cv_layer_begin(1)) + (g >= cv_layer_begin(2)) + (g >= cv_layer_begin(3)); int c = g - cv_layer_begin(L); const int x = L >> 1, nin = (L & 1) ? I_QKV : I_IE;
    ConvDesc d; int item; int sub = 0;
    if (c >= I_FI + I_FO + nin + I_DD) { c -= I_FI + I_FO + nin + I_DD; sub = 1; }
    const int mi = L * 2 + sub;
    if (c < I_FI) { d.W = F.in[7] + (size_t)mi * D * NFFIN; d.Wt = (half_t*)(ws + WS_WFI) + (size_t)mi * NFFIN * D; d.K = D; d.N = NFFIN; d.perm = 1; item = c; }
    else { c -= I_FI;
      if (c < I_FO) { d.W = F.in[8] + (size_t)mi * DFF * D; d.Wt = (half_t*)(ws + WS_WFO) + (size_t)mi * D * DFF; d.K = DFF; d.N = D; d.perm = 0; item = c; }
      else { c -= I_FO;
        if (c < nin) { item = c; d.K = D; if (L & 1) { d.W = F.in[14] + (size_t)x * D * NQKV; d.Wt = (half_t*)(ws + WS_WQKV) + (size_t)x * NQKV * D; d.N = NQKV; d.perm = 2; } else { d.W = F.in[9] + (size_t)x * D * NEV; d.Wt = (half_t*)(ws + WS_WIE) + (size_t)x * NEV * D; d.N = NEV; d.perm = 0; } }
        else { item = c - nin; d.K = D; d.N = D; d.perm = 0; d.W = ((L & 1) ? F.in[15] : F.in[10]) + (size_t)x * D * D; d.Wt = (half_t*)(ws + ((L & 1) ? WS_WOO : WS_WOE)) + (size_t)x * D * D; } } }
    const int ntn = d.N >> 5; d.k0 = (item / ntn) * 64; d.n0 = (item % ntn) * 32; return d;
}
__device__ __forceinline__ void conv_range(Frame& F, int begin, int end, int j, int nidle) {
    LAS float* scr = (LAS float*)(F.lds + F.wave * 16384); const int lane = F.lane, stride = nidle * NWAVES;
    int t = begin + j * NWAVES + F.wave; if (t >= end) return;
    ConvDesc dn = conv_decode(F, t); f32x4 vn[8];
#define CV_LOAD() do { _Pragma("unroll") for (int _i = 0; _i < 8; ++_i) vn[_i] = __builtin_nontemporal_load((const f32x4*)(dn.W + (size_t)(dn.k0 + _i * 8 + (lane >> 3)) * dn.N + dn.n0 + 4 * (lane & 7))); } while (0)
    CV_LOAD();
    while (t < end) {
        const ConvDesc d = dn; f32x4 v[8];
#pragma unroll
        for (int i = 0; i < 8; ++i) v[i] = vn[i];
        const int tn = t + stride;
        if (tn < end) { dn = conv_decode(F, tn); CV_LOAD(); }
#pragma unroll
        for (int i = 0; i < 8; ++i) { LAS float* p = scr + (i * 8 + (lane >> 3)) * 33 + 4 * (lane & 7); p[0] = v[i][0]; p[1] = v[i][1]; p[2] = v[i][2]; p[3] = v[i][3]; }
        asm volatile("s_waitcnt lgkmcnt(0)" ::: "memory"); __builtin_amdgcn_wave_barrier();
#pragma unroll
        for (int i = 0; i < 4; ++i) { const int n = 8 * i + (lane >> 3), kc = 8 * (lane & 7); h8 o;
#pragma unroll
            for (int jj = 0; jj < 8; ++jj) o[jj] = (half_t)scr[(kc + jj) * 33 + n];
            const int nn = d.n0 + n, dr = d.perm == 1 ? dst_row<1>(nn) : (d.perm == 2 ? dst_row<2>(nn) : nn);
            __builtin_nontemporal_store(opround(o, (d.perm == 1 || d.K == DFF) ? DROP_FFN : DROP_MIX), (h8*)(d.Wt + (size_t)dr * d.K + d.k0 + kc)); }
        asm volatile("s_waitcnt lgkmcnt(0)" ::: "memory"); __builtin_amdgcn_wave_barrier();
        t = tn;
    }
#undef CV_LOAD
}
__device__ __forceinline__ void filler_tasks(Frame& F, int begin, int end, int total_units) {
    const int rem = total_units % F.G; int j = F.bid - rem, nidle = F.G - rem;
    if (rem == 0) { j = F.bid; nidle = F.G; }
    if (j < 0) return;
    conv_range(F, begin, end, j, nidle);
}
__device__ __forceinline__ void filler_mod(Frame& F, int L, int begin, int end, int total_units) {
    const int rem = total_units % F.G; int j = F.bid - rem, nidle = F.G - rem;
    if (rem == 0) { j = F.bid; nidle = F.G; }
    if (j < 0) return;
    for (int t = begin + j * NWAVES + F.wave; t < end; t += nidle * NWAVES) setup_task(F, L, t);
}
__device__ __forceinline__ void prologue0_phase(Frame& F) {
    unsigned char* ws = F.ws; const int gt = F.bid * NTHREADS + F.tid, nt = F.G * NTHREADS;
    { const int gw = F.bid * NWAVES + F.wave, NGW = F.G * NWAVES;
      for (int t = gw; t < (N_LAUNCH_MODE == 0 ? 1 : DEPTH) * NT_MOD; t += NGW) setup_task(F, t / NT_MOD, t % NT_MOD); }
    { float* LB = (float*)(ws + WS_LB); const float* lg = F.in[12];
      for (int i = gt; i < 2 * 1024; i += nt) { const int d = i >> 10, j = i & 1023; const float l0 = lg[(d * 2 + 0) * 1024 + j], l1 = lg[(d * 2 + 1) * 1024 + j];
          LB[(d * 2 + 0) * 1024 + j] = 0.f; LB[(d * 2 + 1) * 1024 + j] = 1.f / (1.f + expf(l0 - l1)); }
      float* RC = (float*)(ws + WS_ROPE); float* RS = RC + 128 * 32;
      for (int i = gt; i < 128 * 32; i += nt) { const int pos = i >> 5, j = i & 31; const float inv = powf(10000.0f, -(float)j / 32.0f); const float ang = (float)pos * inv; RC[i] = cosf(ang); RS[i] = sinf(ang); } }
    { h8* Hd = (h8*)(ws + WS_H); const f32x4* xs = (const f32x4*)F.in[0]; const f32x4* cs = (const f32x4*)F.in[2];
      const size_t nx = (size_t)SEQ * D / 8, nc = (size_t)NCTX * D / 8;
      for (size_t i = gt; i < nx; i += nt) Hd[i] = pack8(xs[2 * i], xs[2 * i + 1]);
      for (size_t i = gt; i < nc; i += nt) Hd[nx + i] = pack8(cs[2 * i], cs[2 * i + 1]); }
}
__device__ __forceinline__ void prologue_phase(Frame& F) {
    for (int L = 0; L < (N_LAUNCH_MODE == 0 ? 1 : DEPTH); ++L) mod_reduce(F, L, 0, MODN, true);
    conv_range(F, 0, CV_PRO, F.bid, F.G);
}

__device__ __forceinline__ void adaln_phase(Frame& F, const float* g, const float* mod_lat, const float* mod_ctx, int row_end, int nparts, int drop) {
    const int gw = F.bid * NWAVES + F.wave, NGW = F.G * NWAVES;
    half_t* H = (half_t*)(F.ws + WS_H); half_t* U = (half_t*)(F.ws + WS_U); const float* PART = (const float*)(F.ws + WS_PART);
    if (nparts > 0 && row_end > SEQ) {
        LAS float* red = (LAS float*)F.lds;
        for (int cr = F.bid; cr < NCTX; cr += F.G) {
            const int c = 4 * F.tid; half_t* hr = H + (size_t)(SEQ + cr) * D + c; const float* pr = PART + (size_t)cr * D + c;
            const h4 hh = *(const h4*)hr; f32x4 x = {(float)hh[0], (float)hh[1], (float)hh[2], (float)hh[3]};
            for (int p0 = 0; p0 < nparts; p0 += 11) { f32x4 pv[11];
#pragma unroll
                for (int p = 0; p < 11; ++p) pv[p] = (p0 + p < nparts) ? *(const f32x4*)(pr + (size_t)(p0 + p) * NCTX * D) : (f32x4){0.f, 0.f, 0.f, 0.f};
#pragma unroll
                for (int p = 0; p < 11; ++p) x += pv[p]; }
            h4 hn;
#pragma unroll
            for (int j = 0; j < 4; ++j) { hn[j] = (half_t)x[j]; x[j] = (float)hn[j]; }
            *(h4*)hr = hn;
            float ss = wave_sum(x[0] * x[0] + x[1] * x[1] + x[2] * x[2] + x[3] * x[3]);
            __syncthreads();
            if (F.lane == 0) red[F.wave] = ss;
            __syncthreads();
            ss = ((red[0] + red[1]) + (red[2] + red[3])) + ((red[4] + red[5]) + (red[6] + red[7]));
            const float rstd = rsqrtf(ss * (1.0f / D) + EPS); const float* md = mod_lat + MODN;
            const f32x4 gv = *(const f32x4*)(g + c), sh = *(const f32x4*)(md + c), sc = *(const f32x4*)(md + D + c);
            const f32x4 o = (x * rstd * gv) * (sc + 1.0f) + sh; h4 oh;
#pragma unroll
            for (int j = 0; j < 4; ++j) oh[j] = (half_t)o[j];
            *(h4*)(U + (size_t)(SEQ + cr) * D + c) = opround(oh, drop);
        }
        row_end = SEQ; nparts = 0;
    }
    h8 xn[4]; int row = gw;
    if (row < row_end) {
#pragma unroll
        for (int i = 0; i < 4; ++i) xn[i] = *(const h8*)(H + (size_t)row * D + 8 * (F.lane + 64 * i)); }
    f32x4 Gv[4][2], Sv[4][2];
#pragma unroll
    for (int i = 0; i < 4; ++i)
#pragma unroll
        for (int h = 0; h < 2; ++h) { const int c = 8 * (F.lane + 64 * i) + 4 * h; Gv[i][h] = *(const f32x4*)(g + c) * (*(const f32x4*)(mod_lat + D + c) + 1.0f); Sv[i][h] = *(const f32x4*)(mod_lat + c); }
    while (row < row_end) {
        f32x4 x[4][2];
#pragma unroll
        for (int i = 0; i < 4; ++i)
#pragma unroll
            for (int j = 0; j < 4; ++j) { x[i][0][j] = (float)xn[i][j]; x[i][1][j] = (float)xn[i][4 + j]; }
        const int nrow = row + NGW;
        if (nrow < row_end) {
#pragma unroll
            for (int i = 0; i < 4; ++i) xn[i] = *(const h8*)(H + (size_t)nrow * D + 8 * (F.lane + 64 * i)); }
        float ss = 0.f;
#pragma unroll
        for (int i = 0; i < 4; ++i)
#pragma unroll
            for (int j = 0; j < 4; ++j) ss += x[i][0][j] * x[i][0][j] + x[i][1][j] * x[i][1][j];
        ss = wave_sum(ss); const float rstd = rsqrtf(ss * (1.0f / D) + EPS);
        if (row >= SEQ) {
            const float* md = mod_lat + MODN;
#pragma unroll
            for (int i = 0; i < 4; ++i) { const int c = 8 * (F.lane + 64 * i); f32x4 o[2];
#pragma unroll
                for (int h = 0; h < 2; ++h) { const f32x4 gv = *(const f32x4*)(g + c + 4 * h), sh = *(const f32x4*)(md + c + 4 * h), sc = *(const f32x4*)(md + D + c + 4 * h);
                    o[h] = (x[i][h] * rstd * gv) * (sc + 1.0f) + sh; }
                *(h8*)(U + (size_t)row * D + c) = opround(pack8(o[0], o[1]), drop); }
        } else {
#pragma unroll
            for (int i = 0; i < 4; ++i) { const int c = 8 * (F.lane + 64 * i);
                *(h8*)(U + (size_t)row * D + c) = opround(pack8(x[i][0] * rstd * Gv[i][0] + Sv[i][0], x[i][1] * rstd * Gv[i][1] + Sv[i][1]), drop); }
        }
        row = nrow;
    }
    (void)mod_ctx;
}
__device__ __forceinline__ void final_norm_phase(Frame& F) {
    const int gw = F.bid * NWAVES + F.wave, NGW = F.G * NWAVES;
    const half_t* H = (const half_t*)(F.ws + WS_H); const float* g = F.in[17];
    for (int row = gw; row < SEQ; row += NGW) {
        f32x4 x[4][2]; float ss = 0.f;
#pragma unroll
        for (int i = 0; i < 4; ++i) { const h8 hv = *(const h8*)(H + (size_t)row * D + 8 * (F.lane + 64 * i));
#pragma unroll
            for (int j = 0; j < 4; ++j) { x[i][0][j] = (float)hv[j]; x[i][1][j] = (float)hv[4 + j]; ss += x[i][0][j] * x[i][0][j] + x[i][1][j] * x[i][1][j]; } }
        ss = wave_sum(ss); const float rstd = rsqrtf(ss * (1.0f / D) + EPS);
#pragma unroll
        for (int i = 0; i < 4; ++i) { const int c = 8 * (F.lane + 64 * i);
#pragma unroll
            for (int h = 0; h < 2; ++h) *(f32x4*)(F.out + (size_t)row * D + c + 4 * h) = x[i][h] * rstd * *(const f32x4*)(g + c + 4 * h); }
    }
}

constexpr int AT_KP = 136, AT_VP = 68;
constexpr int AT_KBYTES = 64 * AT_KP * 2, AT_VBYTES = 128 * AT_VP * 2, AT_BUF = AT_KBYTES + AT_VBYTES, AT_BIAS_OFF = 2 * AT_BUF, AT_OUT_OFF = AT_BIAS_OFF + 2048;
template <int MODE, int PV = 0>
__device__ __forceinline__ void attn_item(Frame& F, int it, const float* rpb_e, const float* sinkp) {
    const int w = F.wave, q = F.lane & 31, hh = F.lane >> 5;
    constexpr bool EVEN = MODE < 2;
    const half_t* Qb; const half_t* Kb; const half_t* VTb; half_t* Ob; int qtok, lt0 = 0, lt1 = 0;
    constexpr int qpitch = EVEN ? 1024 : 2048, kpitch = EVEN ? 1024 : 512;
    int r = 0, qc = 0, c0 = 0, r0w = 0, q0w = 0; float sink2 = 0.f;
    if (MODE == 0) { const int rg = it >> 3, h = it & 7; r = 4 * rg + (w >> 1); qc = 32 * (w & 1) + q; qtok = 64 * r + qc; c0 = min(max(qc - 8, 0), 48); r0w = min(max(r - 4, 0), 120);
        lt0 = min(max(4 * rg - 4, 0), 120); lt1 = min(max(4 * rg - 1, 0), 120) + 8;
        Qb = (const half_t*)(F.ws + WS_QA) + h * 128; Kb = (const half_t*)(F.ws + WS_KA) + h * 128; VTb = (const half_t*)(F.ws + WS_VTA) + (size_t)h * 128 * MR; Ob = (half_t*)(F.ws + WS_Y) + h * 128;
    } else if (MODE == 1) { const int h = it; qtok = SEQ + 32 * w + q;
        Qb = (const half_t*)(F.ws + WS_QA) + h * 128; Kb = (const half_t*)(F.ws + WS_KA) + h * 128; VTb = (const half_t*)(F.ws + WS_VTA) + (size_t)h * 128 * MR; Ob = (half_t*)(F.ws + WS_Y) + h * 128;
    } else if (MODE == 2) { const int nb = it >> 3, kvh = (it >> 1) & 3, gh = it & 1, hq = 4 * kvh + 2 * gh + (w >> 2); q0w = 128 * nb + 32 * (w & 3); qtok = q0w + q;
        lt0 = max(0, 2 * nb - 2); lt1 = min(128, 2 * nb + 4); sink2 = sinkp[hq] * LOG2E;
        Qb = (const half_t*)(F.ws + WS_Q) + hq * 128; Kb = (const half_t*)(F.ws + WS_K) + kvh * 128; VTb = (const half_t*)(F.ws + WS_VT) + (size_t)kvh * 128 * MR; Ob = (half_t*)(F.ws + WS_Y) + hq * 128;
    } else { const int hq = it, kvh = hq >> 2; qtok = SEQ + 32 * w + q; sink2 = sinkp[hq] * LOG2E;
        Qb = (const half_t*)(F.ws + WS_Q) + hq * 128; Kb = (const half_t*)(F.ws + WS_K) + kvh * 128; VTb = (const half_t*)(F.ws + WS_VT) + (size_t)kvh * 128 * MR; Ob = (half_t*)(F.ws + WS_Y) + hq * 128;
    }
    const int nl = lt1 - lt0, ntiles = nl + 4;
    __syncthreads();
    LAS float* bt = (LAS float*)(F.lds + AT_BIAS_OFF);
    if (MODE == 0) { const int h = it & 7; for (int i = F.tid; i < 15 * 31; i += NTHREADS) bt[i] = rpb_e[h * 15 * 31 + i] * LOG2E; }
    h8 qf[8];
#pragma unroll
    for (int ks = 0; ks < 8; ++ks) qf[ks] = *(const h8*)(Qb + (size_t)qtok * qpitch + 16 * ks + 8 * hh);
    f32x16 oacc[4];
#pragma unroll
    for (int dt = 0; dt < 4; ++dt)
#pragma unroll
        for (int i = 0; i < 16; ++i) oacc[dt][i] = 0.f;
    float m_run = -INFINITY, l_run = 0.f;
    h8 kreg[2], vreg[2];
#define AT_TOK0(ti) ((ti) < nl ? 64 * (lt0 + (ti)) : SEQ + 64 * ((ti) - nl))
#define AT_LOAD(ti) do { const int _t0 = AT_TOK0(ti); _Pragma("unroll") for (int _i = 0; _i < 2; ++_i) { const int _c = F.tid + NTHREADS * _i; \
        kreg[_i] = *(const h8*)(Kb + (size_t)(_t0 + (_c >> 4)) * kpitch + 8 * (_c & 15)); vreg[_i] = *(const h8*)(VTb + (size_t)(_c >> 3) * MR + _t0 + 8 * (_c & 7)); } } while (0)
    if (!(PV & 4)) AT_LOAD(0);
    for (int ti = 0; ti < ntiles; ++ti) {
        LAS half_t* Kl = (LAS half_t*)(F.lds + (ti & 1) * AT_BUF); LAS half_t* Vl = (LAS half_t*)(F.lds + (ti & 1) * AT_BUF + AT_KBYTES);
        if (!(PV & 4))
#pragma unroll
        for (int i = 0; i < 2; ++i) { const int c = F.tid + NTHREADS * i; *(LAS h8*)(Kl + (c >> 4) * AT_KP + 8 * (c & 15)) = kreg[i];
            LAS h4* vp = (LAS h4*)(Vl + (c >> 3) * AT_VP + 8 * (c & 7)); h4 a, b;
#pragma unroll
            for (int j = 0; j < 4; ++j) { a[j] = vreg[i][j]; b[j] = vreg[i][4 + j]; }
            vp[0] = a; vp[1] = b; }
        __syncthreads();
        if (ti + 1 < ntiles && !(PV & 4)) AT_LOAD(ti + 1);
        const bool local = ti < nl; const int kt0 = AT_TOK0(ti); bool need = true;
        if (MODE == 0 && local) { const int kr = lt0 + ti; need = (kr >= r0w) && (kr < r0w + 8); }
        if (MODE == 2 && local) need = (kt0 + 63 >= q0w - 128) && (kt0 <= q0w + 31 + 128);
        if (need) {
            f32x16 s0, s1; const f32x16 zero16 = {0.f, 0.f, 0.f, 0.f, 0.f, 0.f, 0.f, 0.f, 0.f, 0.f, 0.f, 0.f, 0.f, 0.f, 0.f, 0.f};
            { h8 a0[8], a1[8];
#pragma unroll
              for (int ks = 0; ks < 8; ++ks) a0[ks] = *(const LAS h8*)(Kl + q * AT_KP + 16 * ks + 8 * hh);
              __builtin_amdgcn_sched_barrier(0);
#pragma unroll
              for (int ks = 0; ks < 4; ++ks) s0 = __builtin_amdgcn_mfma_f32_32x32x16_f16(a0[ks], qf[ks], ks == 0 ? zero16 : s0, 0, 0, 0);
#pragma unroll
              for (int ks = 0; ks < 4; ++ks) a1[ks] = *(const LAS h8*)(Kl + (32 + q) * AT_KP + 16 * ks + 8 * hh);
              __builtin_amdgcn_sched_barrier(0);
#pragma unroll
              for (int ks = 4; ks < 8; ++ks) s0 = __builtin_amdgcn_mfma_f32_32x32x16_f16(a0[ks], qf[ks], s0, 0, 0, 0);
#pragma unroll
              for (int ks = 4; ks < 8; ++ks) a1[ks] = *(const LAS h8*)(Kl + (32 + q) * AT_KP + 16 * ks + 8 * hh);
              __builtin_amdgcn_sched_barrier(0);
#pragma unroll
              for (int ks = 0; ks < 8; ++ks) s1 = __builtin_amdgcn_mfma_f32_32x32x16_f16(a1[ks], qf[ks], ks == 0 ? zero16 : s1, 0, 0, 0); }
            if (MODE == 0 && local && !(PV & 1)) { const int bbase = (lt0 + ti - r + 7) * 31 + 15 - qc;
#pragma unroll
                for (int i = 0; i < 16; ++i) { const int k0 = (i & 3) + 8 * (i >> 2) + 4 * hh, k1 = k0 + 32;
                    const bool v0 = (k0 >= c0) && (k0 < c0 + 16), v1 = (k1 >= c0) && (k1 < c0 + 16);
                    s0[i] = v0 ? s0[i] + bt[v0 ? bbase + k0 : 0] : -INFINITY; s1[i] = v1 ? s1[i] + bt[v1 ? bbase + k1 : 0] : -INFINITY; } }
            if (MODE == 2 && local && !(PV & 1) && !((kt0 >= q0w + 31 - 128) && (kt0 + 63 <= q0w + 128))) { const int dbase = kt0 - qtok;
#pragma unroll
                for (int i = 0; i < 16; ++i) { const int d0 = dbase + (i & 3) + 8 * (i >> 2) + 4 * hh, d1 = d0 + 32;
                    s0[i] = (d0 <= 128 && d0 >= -128) ? s0[i] : -INFINITY; s1[i] = (d1 <= 128 && d1 >= -128) ? s1[i] : -INFINITY; } }
            float psum = 0.f; h8 pf[2][2];
            if (PV & 2) {
#pragma unroll
                for (int i = 0; i < 16; ++i) { pf[0][i >> 3][i & 7] = (half_t)s0[i]; pf[1][i >> 3][i & 7] = (half_t)s1[i]; }
                l_run += 1.f; m_run = 0.f;
            } else {
            float mloc = -INFINITY;
#pragma unroll
            for (int i = 0; i < 16; ++i) mloc = fmaxf(mloc, fmaxf(s0[i], s1[i]));
            mloc = fmaxf(mloc, __shfl_xor(mloc, 32));
            const float m_new = fmaxf(m_run, mloc), m_use = (m_new == -INFINITY) ? 0.f : m_new;
            const float alpha = fast_exp2(m_run - m_use); m_run = m_new;
#pragma unroll
            for (int i = 0; i < 16; ++i) { const float p0 = fast_exp2(s0[i] - m_use), p1 = fast_exp2(s1[i] - m_use); psum += p0 + p1; pf[0][i >> 3][i & 7] = (half_t)p0; pf[1][i >> 3][i & 7] = (half_t)p1; }
            l_run = l_run * alpha + psum;
            if (__any(alpha != 1.0f)) {
#pragma unroll
                for (int dt = 0; dt < 4; ++dt) oacc[dt] = oacc[dt] * alpha; }
            }
#pragma unroll
            for (int dp = 0; dp < 2; ++dp) {
                h4 va[2][4], vb[2][4];
#pragma unroll
                for (int d2 = 0; d2 < 2; ++d2)
#pragma unroll
                    for (int x = 0; x < 4; ++x) { const LAS h4* vp = (const LAS h4*)(Vl + (32 * (2 * dp + d2) + q) * AT_VP + 32 * (x >> 1) + 16 * (x & 1) + 4 * hh); va[d2][x] = vp[0]; vb[d2][x] = vp[2]; }
                __builtin_amdgcn_sched_barrier(0);
#pragma unroll
                for (int d2 = 0; d2 < 2; ++d2)
#pragma unroll
                    for (int x = 0; x < 4; ++x) { h8 a;
#pragma unroll
                        for (int j = 0; j < 4; ++j) { a[j] = va[d2][x][j]; a[4 + j] = vb[d2][x][j]; }
                        oacc[2 * dp + d2] = __builtin_amdgcn_mfma_f32_32x32x16_f16(a, pf[x >> 1][x & 1], oacc[2 * dp + d2], 0, 0, 0); }
            }
        }
    }
#undef AT_LOAD
#undef AT_TOK0
    float lt = l_run + __shfl_xor(l_run, 32);
    if (MODE >= 2) lt += fast_exp2(sink2 - m_run);
    const float inv = 1.0f / lt;
    int ln = F.lane; asm volatile("" : "+v"(ln));
    const int q2 = ln & 31, hh2 = ln >> 5;
    LAS half_t* Ot = (LAS half_t*)(F.lds + AT_OUT_OFF + w * (32 * AT_KP * 2));
#pragma unroll
    for (int dt = 0; dt < 4; ++dt)
#pragma unroll
        for (int g = 0; g < 4; ++g) { h4 o;
#pragma unroll
            for (int j = 0; j < 4; ++j) o[j] = (half_t)(oacc[dt][4 * g + j] * inv);
            *(LAS h4*)(Ot + q2 * AT_KP + 32 * dt + 8 * g + 4 * hh2) = o; }
    asm volatile("s_waitcnt lgkmcnt(0)" ::: "memory"); __builtin_amdgcn_wave_barrier();
    { const int rr = ln >> 4, cc = ln & 15; const int qbase = qtok - q;
#pragma unroll
      for (int i = 0; i < 8; ++i) { const h8 v = *(const LAS h8*)(Ot + (4 * i + rr) * AT_KP + 8 * cc); *(h8*)(Ob + (size_t)(qbase + 4 * i + rr) * D + 8 * cc) = v; } }
    asm volatile("s_waitcnt lgkmcnt(0)" ::: "memory"); __builtin_amdgcn_wave_barrier();
}
template <int MLAT, int MCTX, int PV = 0>
__device__ __forceinline__ void attn_phase(Frame& F, const float* rpb_e, const float* sinkp, bool need_ctx) {
    constexpr int NLAT = MLAT == 0 ? 256 : 512, NC = MCTX == 1 ? 8 : 16;
    for (int it = F.bid; it < NLAT; it += F.G) attn_item<MLAT, PV>(F, it, rpb_e, sinkp);
    if (need_ctx) for (int it = F.G - 1 - F.bid; it < NC; it += F.G) attn_item<MCTX, PV>(F, it, rpb_e, sinkp);
}

typedef __bf16 bf8 __attribute__((ext_vector_type(8)));
typedef __bf16 bf2 __attribute__((ext_vector_type(2)));
constexpr int H3_PT = 0, H3_RED = 4096, H3_QP = 4608, H3_QHI = 22016, H3_QLO = 39424, H3_KHI = 56832, H3_KLO = 74240, H3_VS = 91648, H3_P = 110080, H3_KPT = H3_QP, H3_OST = 23040;
constexpr int HP_D = 136, HP_S = 72;
__device__ __forceinline__ int hg_cidx(int dir, int rc) { return dir == 0 ? (rc + 4) % 132 : 131 - rc; }
__device__ __forceinline__ void hg_cumsum(Frame& F, const f32x2 (&lf)[8], int dir, f32x2 (&b)[8], f32x2& tot, f32x2& mid) {
    const int jp = F.tid & 63, part = F.tid >> 6; LAS f32x2* pt = (LAS f32x2*)(F.lds + H3_PT);
    f32x2 run = {0.f, 0.f};
    if (dir == 0) {
#pragma unroll
        for (int i = 0; i < 8; ++i) { run += lf[i]; b[i] = run; }
    } else {
#pragma unroll
        for (int i = 7; i >= 0; --i) { run += lf[i]; b[i] = run; }
    }
    pt[part * 64 + jp] = run;
    __syncthreads();
    f32x2 p[8];
#pragma unroll
    for (int i = 0; i < 8; ++i) p[i] = pt[i * 64 + jp];
    f32x2 pre = {0.f, 0.f};
#pragma unroll
    for (int i = 0; i < 8; ++i) { const bool take = dir == 0 ? (i < part) : (i > part); if (take) pre += p[i]; }
#pragma unroll
    for (int i = 0; i < 8; ++i) b[i] += pre;
    const f32x2 lo = (p[0] + p[1]) + (p[2] + p[3]), hi = (p[4] + p[5]) + (p[6] + p[7]);
    tot = lo + hi; mid = dir == 0 ? lo : hi;
}
__device__ __forceinline__ void hg_load_vs(Frame& F, int row0, int h) {
    const half_t* VTB = (const half_t*)(F.ws + WS_VTB) + (size_t)h * 128 * MR; LAS half_t* Vs = (LAS half_t*)(F.lds + H3_VS);
#pragma unroll
    for (int i = 0; i < 2; ++i) { const int c = F.tid + NTHREADS * i; *(LAS h8*)(Vs + (c >> 3) * HP_S + 8 * (c & 7)) = *(const h8*)(VTB + (size_t)(c >> 3) * MR + row0 + 8 * (c & 7)); }
}
__device__ __forceinline__ void hgrn_local_phase(Frame& F) {
    const half_t* LF = (const half_t*)(F.ws + WS_LF); half_t* US = (half_t*)(F.ws + WS_US); float* DEC = (float*)(F.ws + WS_DEC);
    LAS half_t* Vs = (LAS half_t*)(F.lds + H3_VS); LAS half_t* KpT = (LAS half_t*)(F.lds + H3_KPT);
    const int w = F.wave, fr = F.lane & 15, fq = F.lane >> 4, jp = F.tid & 63, part = F.tid >> 6;
    for (int it = F.bid; it < 132 * 8; it += F.G) {
        const int rc = it >> 3, h = it & 7, row0 = 64 * rc;
        __syncthreads();
        f32x2 lfa[2][8]; h2 kka[2][8];
#pragma unroll
        for (int d = 0; d < 2; ++d)
#pragma unroll
            for (int i = 0; i < 8; ++i) { const size_t o = (size_t)d * MR * 1024 + (size_t)(row0 + 8 * part + i) * 1024 + h * 128 + 2 * jp; { const h2 l2 = *(const h2*)(LF + o); lfa[d][i][0] = (float)l2[0]; lfa[d][i][1] = (float)l2[1]; } kka[d][i][0] = (half_t)(1.0f - fast_exp2(lfa[d][i][0] * LOG2E)); kka[d][i][1] = (half_t)(1.0f - fast_exp2(lfa[d][i][1] * LOG2E)); }
        hg_load_vs(F, row0, h);
#pragma unroll
        for (int dir = 0; dir < 2; ++dir) {
            const int cidx = hg_cidx(dir, rc);
            f32x2 b[8], tot, mid; const h2 (&kk)[8] = kka[dir];
            if (dir) __syncthreads();
            hg_cumsum(F, lfa[dir], dir, b, tot, mid);
            h8 o0, o1;
#pragma unroll
            for (int i = 0; i < 8; ++i) { o0[i] = (half_t)((float)kk[i][0] * __expf(tot[0] - b[i][0])); o1[i] = (half_t)((float)kk[i][1] * __expf(tot[1] - b[i][1])); }
            *(LAS h8*)(KpT + (2 * jp) * HP_S + 8 * part) = o0; *(LAS h8*)(KpT + (2 * jp + 1) * HP_S + 8 * part) = o1;
            if (part == 0) { f32x2 d; d[0] = __expf(tot[0]); d[1] = __expf(tot[1]); *(f32x2*)(DEC + ((size_t)(dir * 132 + cidx) * 8 + h) * 128 + 2 * jp) = d; }
            __syncthreads();
            half_t* Ub = US + ((size_t)(dir * 132 + cidx) * 8 + h) * 16384;
            h8 bv[2];
#pragma unroll
            for (int ks = 0; ks < 2; ++ks) bv[ks] = *(const LAS h8*)(Vs + (16 * w + fr) * HP_S + 32 * ks + 8 * fq);
            LAS half_t* Ost = (LAS half_t*)(F.lds + H3_OST + w * (16 * HP_D * 2));
#pragma unroll
            for (int dkt = 0; dkt < 8; ++dkt) { f32x4 acc = {0.f, 0.f, 0.f, 0.f};
#pragma unroll
                for (int ks = 0; ks < 2; ++ks) { const h8 a = *(const LAS h8*)(KpT + (16 * dkt + fr) * HP_S + 32 * ks + 8 * fq); acc = __builtin_amdgcn_mfma_f32_16x16x32_f16(a, bv[ks], acc, 0, 0, 0); }
                h4 o;
#pragma unroll
                for (int r = 0; r < 4; ++r) o[r] = (half_t)acc[r];
                *(LAS h4*)(Ost + fr * HP_D + 16 * dkt + 4 * fq) = o; }
            asm volatile("s_waitcnt lgkmcnt(0)" ::: "memory"); __builtin_amdgcn_wave_barrier();
#pragma unroll
            for (int i = 0; i < 4; ++i) { const int rr = 4 * i + (F.lane >> 4), cc = F.lane & 15; *(h8*)(Ub + (size_t)(16 * w + rr) * 128 + 8 * cc) = *(const LAS h8*)(Ost + rr * HP_D + 8 * cc); }
            asm volatile("s_waitcnt lgkmcnt(0)" ::: "memory"); __builtin_amdgcn_wave_barrier();
        }
    }
}
__device__ __forceinline__ void hgrn_scan_phase(Frame& F) {
    if (F.tid >= 256) return;
    half_t* US = (half_t*)(F.ws + WS_US); const float* DEC = (const float*)(F.ws + WS_DEC);
    for (int e = F.bid * 256 + F.tid; e < 2 * 8 * 128 * 32; e += F.G * 256) {
        const int dk4 = e & 31, dv = (e >> 5) & 127, h = (e >> 12) & 7, dir = e >> 15;
        half_t* up = US + ((size_t)(dir * 132) * 8 + h) * 16384 + dv * 128 + dk4 * 4; const float* dp = DEC + ((size_t)(dir * 132) * 8 + h) * 128 + dk4 * 4;
        f32x4 S = {0.f, 0.f, 0.f, 0.f};
        for (int c = 0; c < 132; c += 12) {
            h4 u[12]; f32x4 d[12];
#pragma unroll
            for (int i = 0; i < 12; ++i) { u[i] = *(const h4*)(up + (size_t)(c + i) * 8 * 16384); d[i] = *(const f32x4*)(dp + (size_t)(c + i) * 8 * 128); }
#pragma unroll
            for (int i = 0; i < 12; ++i) { h4 so;
#pragma unroll
                for (int r = 0; r < 4; ++r) so[r] = (half_t)S[r];
                *(h4*)(up + (size_t)(c + i) * 8 * 16384) = so;
#pragma unroll
                for (int r = 0; r < 4; ++r) S[r] = d[i][r] * S[r] + (float)u[i][r]; }
        }
    }
}
template <int HV = 0>
__device__ __forceinline__ void hgrn_out_phase(Frame& F) {
    const half_t* LF = (const half_t*)(F.ws + WS_LF); const half_t* US = (const half_t*)(F.ws + WS_US); const half_t* QB = (const half_t*)(F.ws + WS_QB);
    const half_t* GS = (const half_t*)(F.ws + WS_GS); half_t* Yo = (half_t*)(F.ws + WS_Y);
    LAS half_t* Qp = (LAS half_t*)(F.lds + H3_QP); LAS __bf16* Qhi = (LAS __bf16*)(F.lds + H3_QHI); LAS __bf16* Qlo = (LAS __bf16*)(F.lds + H3_QLO);
    LAS __bf16* Khi = (LAS __bf16*)(F.lds + H3_KHI); LAS __bf16* Klo = (LAS __bf16*)(F.lds + H3_KLO);
    LAS half_t* Vs = (LAS half_t*)(F.lds + H3_VS); LAS half_t* P = (LAS half_t*)(F.lds + H3_P); LAS float* red = (LAS float*)(F.lds + H3_RED);
    const int w = F.wave, fr = F.lane & 15, fq = F.lane >> 4, ti = w & 3, tt0 = 16 * ti, dv0 = 16 * w, jp = F.tid & 63, part = F.tid >> 6;
    for (int it = F.bid; it < 132 * 8; it += F.G) {
        const int rc = it >> 3, h = it & 7, row0 = 64 * rc;
        __syncthreads();
        h2 qq[8]; f32x2 lfa[2][8]; h2 kka[2][8];
#pragma unroll
        for (int i = 0; i < 8; ++i) { if (HV & 4) { qq[i][0] = (half_t)0.5f; qq[i][1] = (half_t)0.25f; } else qq[i] = *(const h2*)(QB + (size_t)(row0 + 8 * part + i) * 1024 + h * 128 + 2 * jp); }
#pragma unroll
        for (int d = 0; d < 2; ++d)
#pragma unroll
            for (int i = 0; i < 8; ++i) { const size_t o = (size_t)d * MR * 1024 + (size_t)(row0 + 8 * part + i) * 1024 + h * 128 + 2 * jp;
                if (HV & 4) { lfa[d][i] = (f32x2){-0.5f, -0.25f}; kka[d][i][0] = (half_t)0.5f; kka[d][i][1] = (half_t)0.25f; } else { { const h2 l2 = *(const h2*)(LF + o); lfa[d][i][0] = (float)l2[0]; lfa[d][i][1] = (float)l2[1]; } kka[d][i][0] = (half_t)(1.0f - fast_exp2(lfa[d][i][0] * LOG2E)); kka[d][i][1] = (half_t)(1.0f - fast_exp2(lfa[d][i][1] * LOG2E)); } }
        hg_load_vs(F, row0, h);
        f32x4 acc[4];
#pragma unroll
        for (int i = 0; i < 4; ++i) acc[i] = (f32x4){0.f, 0.f, 0.f, 0.f};
#pragma unroll
        for (int dir = 0; dir < 2; ++dir) {
            const int cidx = hg_cidx(dir, rc);
            f32x2 b[8], tot, mid; const h2 (&kk)[8] = kka[dir];
            h8 sfr[4];
            { const half_t* Sb = US + ((size_t)(dir * 132 + cidx) * 8 + h) * 16384;
#pragma unroll
              for (int ks = 0; ks < 4; ++ks) sfr[ks] = *(const h8*)(Sb + (size_t)(dv0 + fr) * 128 + 32 * ks + 8 * fq); }
            if (dir) __syncthreads();
            hg_cumsum(F, lfa[dir], dir, b, tot, mid);
            if (!(HV & 1))
#pragma unroll
            for (int i = 0; i < 8; ++i) { const int t = 8 * part + i; h2 qp; bf2 qh_, ql_, kh_, kl_;
#pragma unroll
                for (int c = 0; c < 2; ++c) { const float q = (float)qq[i][c], k = (float)kk[i][c], bb = b[i][c], dm = bb - mid[c];
                    qp[c] = (half_t)(q * __expf(bb));
                    const float qv = q * __expf(fminf(fmaxf(dm, -80.f), 80.f)), kv = k * __expf(fminf(fmaxf(-dm, -80.f), 80.f));
                    const __bf16 qh1 = (__bf16)qv, kh1 = (__bf16)kv; qh_[c] = qh1; kh_[c] = kh1; ql_[c] = (__bf16)(qv - (float)qh1); kl_[c] = (__bf16)(kv - (float)kh1); }
                *(LAS h2*)(Qp + t * HP_D + 2 * jp) = qp; *(LAS bf2*)(Qhi + t * HP_D + 2 * jp) = qh_; *(LAS bf2*)(Qlo + t * HP_D + 2 * jp) = ql_;
                *(LAS bf2*)(Khi + t * HP_D + 2 * jp) = kh_; *(LAS bf2*)(Klo + t * HP_D + 2 * jp) = kl_; }
            __syncthreads();
#pragma unroll
            for (int ks = 0; ks < 4; ++ks)
#pragma unroll
                for (int tt = 0; tt < 4; ++tt) { const h8 bq = *(const LAS h8*)(Qp + (16 * tt + fr) * HP_D + 32 * ks + 8 * fq);
                    if (!(HV & 2)) acc[tt] = __builtin_amdgcn_mfma_f32_16x16x32_f16(sfr[ks], bq, acc[tt], 0, 0, 0); else acc[tt] += (float)sfr[ks][0] * (float)bq[0]; }
#pragma unroll
            for (int sj = 0; sj < 2; ++sj) { const int si = 2 * (w >> 2) + sj; const bool need = dir == 0 ? (si <= ti) : (si >= ti); f32x4 pa = {0.f, 0.f, 0.f, 0.f};
                if (need && !(HV & 2)) {
#pragma unroll
                    for (int ks = 0; ks < 4; ++ks) { const int ko = 32 * ks + 8 * fq;
                        const bf8 ah = *(const LAS bf8*)(Khi + (16 * si + fr) * HP_D + ko), al = *(const LAS bf8*)(Klo + (16 * si + fr) * HP_D + ko);
                        const bf8 bh = *(const LAS bf8*)(Qhi + (tt0 + fr) * HP_D + ko), bl = *(const LAS bf8*)(Qlo + (tt0 + fr) * HP_D + ko);
                        pa = __builtin_amdgcn_mfma_f32_16x16x32_bf16(ah, bh, pa, 0, 0, 0); pa = __builtin_amdgcn_mfma_f32_16x16x32_bf16(ah, bl, pa, 0, 0, 0); pa = __builtin_amdgcn_mfma_f32_16x16x32_bf16(al, bh, pa, 0, 0, 0); } }
                h4 o;
#pragma unroll
                for (int r = 0; r < 4; ++r) { const int s_ = 16 * si + 4 * fq + r, t_ = tt0 + fr; const bool ok = dir == 0 ? (s_ <= t_) : (s_ >= t_); o[r] = (half_t)(ok ? pa[r] : 0.f); }
                *(LAS h4*)(P + (tt0 + fr) * HP_S + 16 * si + 4 * fq) = o; }
            __syncthreads();
#pragma unroll
            for (int ks = 0; ks < 2; ++ks) { const h8 a = *(const LAS h8*)(Vs + (dv0 + fr) * HP_S + 32 * ks + 8 * fq);
#pragma unroll
                for (int tt = 0; tt < 4; ++tt) { const h8 bp = *(const LAS h8*)(P + (16 * tt + fr) * HP_S + 32 * ks + 8 * fq);
                    if (!(HV & 2)) acc[tt] = __builtin_amdgcn_mfma_f32_16x16x32_f16(a, bp, acc[tt], 0, 0, 0); else acc[tt] += (float)a[0] * (float)bp[0]; } }
        }
        LAS float* red8 = (LAS float*)(F.lds + H3_PT);
#pragma unroll
        for (int tt = 0; tt < 4; ++tt) { float ss = 0.f;
#pragma unroll
            for (int r = 0; r < 4; ++r) ss += acc[tt][r] * acc[tt][r];
            ss += __shfl_xor(ss, 16); ss += __shfl_xor(ss, 32);
            if (fq == 0) red8[w * 64 + 16 * tt + fr] = ss; }
        __syncthreads();
        LAS half_t* Yt = Qp;
#pragma unroll
        for (int tt = 0; tt < 4; ++tt) { const int t = 16 * tt + fr; float ss = 0.f;
#pragma unroll
            for (int x = 0; x < 8; ++x) ss += red8[x * 64 + t];
            const float rstd = rsqrtf(ss * (1.0f / 128.0f) + EPS); h4 y;
#pragma unroll
            for (int r = 0; r < 4; ++r) y[r] = (half_t)(acc[tt][r] * rstd);
            *(LAS h4*)(Yt + t * HP_D + dv0 + 4 * fq) = y; }
        __syncthreads();
#pragma unroll
        for (int i = 0; i < 2; ++i) { const int c = F.tid + NTHREADS * i, t = c >> 4, cc = c & 15; const size_t row = (size_t)row0 + t;
            const h8 yv = *(const LAS h8*)(Yt + t * HP_D + 8 * cc), gs = *(const h8*)(GS + row * 1024 + h * 128 + 8 * cc); h8 o;
#pragma unroll
            for (int j = 0; j < 8; ++j) o[j] = (half_t)((float)yv[j] * (float)gs[j]);
            *(h8*)(Yo + row * D + 1024 + h * 128 + 8 * cc) = o; }
    }
}

constexpr int FFO_SLICE = 8, FFO_PARTS = (DFF / 64) / FFO_SLICE, MO_SLICE = 2, MO_PARTS = (D / 64) / MO_SLICE;
constexpr int PH_EVEN = 12, PH_ODD = 10, NPHASES = 2 + 2 * (PH_EVEN + PH_ODD) + 1;
struct Args { const float* in[18]; float* out; unsigned char* ws; int ph_lo, ph_hi; };

__global__ void __launch_bounds__(NTHREADS, 2) trunk_fwd(Args args) {
    extern __shared__ __attribute__((aligned(16))) unsigned char lds_raw[];
    Frame F; F.lds = (LAS unsigned char*)lds_raw; F.tid = threadIdx.x; F.lane = F.tid & 63; F.wave = __builtin_amdgcn_readfirstlane(F.tid >> 6); F.G = gridDim.x; F.bid = blockIdx.x;
#pragma unroll
    for (int i = 0; i < 18; ++i) F.in[i] = args.in[i];
    F.out = args.out; F.ws = args.ws;
    volatile LAS unsigned* xbw = (volatile LAS unsigned*)(F.lds + LDS_BYTES - 16);
    if (F.tid < 4) xbw[F.tid] = 0u;
    __syncthreads();
    XcdBarrier bar = xcd_barrier_post((unsigned*)(F.ws + WS_BAR), xbw);
    const int lo = args.ph_lo, hi = args.ph_hi; int ph = 0;
#ifndef SITE_MASK
#define SITE_MASK 0xFFFFFFFFu
#endif
#define SITE(n) (((SITE_MASK) >> (n)) & 1u)
#define PH_RUN (ph >= lo && ph < hi)
#define FRESH unsigned char* ws = F.ws; asm volatile("" : "+s"(ws)); asm volatile("" : "+v"(F.tid), "+v"(F.lane)); (void)ws
#define PH_END do { if (ph >= lo && ph + 1 < hi) xcd_barrier(bar); ++ph; } while (0)
#define MODP ((const float*)(ws + WS_MOD))
#define U ((half_t*)(ws + WS_U))
#define HID ((half_t*)(ws + WS_HID))
#define Y ((half_t*)(ws + WS_Y))

    if (PH_RUN) { FRESH; prologue0_phase(F); }
    PH_END;
    if (PH_RUN && SITE(0)) { FRESH; prologue_phase(F); }
    PH_END;

    for (int lp = 0; lp < 2; ++lp) {
#pragma unroll 1
        for (int par = 0; par < 2; ++par) {
            const int l = 2 * lp + par;
#define mod_lat (MODP + ((size_t)l * 2 + 0) * MODN)
#define mod_ctx (MODP + ((size_t)l * 2 + 1) * MODN)
#define ng (F.in[6] + (size_t)l * 3 * D)
            const bool need_ctx = l < DEPTH - 1;
            if (PH_RUN && SITE(1)) { FRESH; if (N_LAUNCH_MODE == 0 && l > 0) mod_reduce(F, l, MODN / 2, MODN, false);
                adaln_phase(F, ng, mod_lat, mod_ctx, MR, l > 0 ? FFO_PARTS : 0, DROP_FFN); }
            PH_END;
            if (PH_RUN && SITE(2)) { FRESH; pg8::Gemm g{U, (const half_t*)(ws + WS_WFI) + (size_t)(l * 2 + 0) * NFFIN * D, MR, NFFIN, D}; pg8::StaticOrder S; S.init(MR, NFFIN, D, F.G, F.bid);
                EpiSwiGLU E{HID}; pg8::gemm_phase(F.lds, g, S, E);
                filler_tasks(F, slot_begin(l, 0), slot_end(l, 0), S.nwg); }
            PH_END;
            if (PH_RUN && SITE(3)) { FRESH; pg8::Gemm g{HID, (const half_t*)(ws + WS_WFO) + (size_t)(l * 2 + 0) * D * DFF, MR, D, DFF}; pg8::StaticOrder S; S.init(SEQ, D, DFF, F.G, F.bid, FFO_SLICE);
                EpiResid E{ws, mod_lat + 2 * D, 0.5f}; pg8::gemm_phase(F.lds, g, S, E);
                if (l < DEPTH - 1 && N_LAUNCH_MODE == 0) filler_mod(F, l + 1, 0, NT_MOD / 2, S.nwg + S.nslu); }
            PH_END;
            if (PH_RUN && SITE(4)) { FRESH; if (N_LAUNCH_MODE == 0 && l < DEPTH - 1) mod_reduce(F, l + 1, 0, MODN / 2, false);
                adaln_phase(F, ng + D, mod_lat + 3 * D, mod_ctx + 3 * D, MR, FFO_PARTS, DROP_MIX); }
            PH_END;
            if (par == 0) {
                const int e = lp;
                if (PH_RUN && SITE(5)) { FRESH; pg8::Gemm g{U, (const half_t*)(ws + WS_WIE) + (size_t)e * NEV * D, MR, NEV, D}; pg8::StaticOrder S; S.init(MR, NEV, D, F.G, F.bid);
                    EpiEven E{(half_t*)(ws + WS_QA), (half_t*)(ws + WS_KA), (half_t*)(ws + WS_VTA), (half_t*)(ws + WS_QB), (half_t*)(ws + WS_VTB), (half_t*)(ws + WS_GS), (half_t*)(ws + WS_KH), (half_t*)(ws + WS_LF),
                              (const float*)(ws + WS_LB) + e * 1024, F.in[13] + e * 1024};
                    pg8::gemm_phase(F.lds, g, S, E);
                    filler_tasks(F, slot_begin(l, 1), slot_end(l, 1), S.nwg); }
                PH_END;
                if (PH_RUN && SITE(6)) { FRESH; attn_phase<0, 1>(F, F.in[11] + (size_t)e * 8 * 15 * 31, nullptr, need_ctx); hgrn_local_phase(F); }
                PH_END;
                if (PH_RUN) { FRESH; hgrn_scan_phase(F); }
                PH_END;
                if (PH_RUN && SITE(8)) { FRESH; hgrn_out_phase(F); }
                PH_END;
                if (PH_RUN && SITE(9)) { FRESH; pg8::Gemm g{Y, (const half_t*)(ws + WS_WOE) + (size_t)e * D * D, MR, D, D}; pg8::StaticOrder S; S.init(SEQ, D, D, F.G, F.bid, need_ctx ? MO_SLICE : 0);
                    EpiResid E{ws, mod_lat + 5 * D, 1.0f}; pg8::gemm_phase(F.lds, g, S, E); }
                PH_END;
            } else {
                const int o = lp;
                if (PH_RUN && SITE(10)) { FRESH; pg8::Gemm g{U, (const half_t*)(ws + WS_WQKV) + (size_t)o * NQKV * D, MR, NQKV, D}; pg8::StaticOrder S; S.init(MR, NQKV, D, F.G, F.bid);
                    EpiOdd E{(half_t*)(ws + WS_Q), (half_t*)(ws + WS_K), (half_t*)(ws + WS_VT), (const float*)(ws + WS_ROPE), (const float*)(ws + WS_ROPE) + 128 * 32};
                    pg8::gemm_phase(F.lds, g, S, E);
                    filler_tasks(F, slot_begin(l, 1), slot_end(l, 1), S.nwg); }
                PH_END;
                if (PH_RUN && SITE(11)) { FRESH; attn_phase<2, 3>(F, nullptr, F.in[16] + o * 16, need_ctx); }
                PH_END;
                if (PH_RUN && SITE(12)) { FRESH; pg8::Gemm g{Y, (const half_t*)(ws + WS_WOO) + (size_t)o * D * D, MR, D, D}; pg8::StaticOrder S; S.init(SEQ, D, D, F.G, F.bid, need_ctx ? MO_SLICE : 0);
                    EpiResid E{ws, mod_lat + 5 * D, 1.0f}; pg8::gemm_phase(F.lds, g, S, E); }
                PH_END;
            }
            if (PH_RUN && SITE(13)) { FRESH; adaln_phase(F, ng + 2 * D, mod_lat + 6 * D, mod_ctx + 6 * D, need_ctx ? MR : SEQ, MO_PARTS, DROP_FFN); }
            PH_END;
            if (PH_RUN && SITE(14)) { FRESH; pg8::Gemm g{U, (const half_t*)(ws + WS_WFI) + (size_t)(l * 2 + 1) * NFFIN * D, MR, NFFIN, D}; pg8::StaticOrder S; S.init(need_ctx ? MR : SEQ, NFFIN, D, F.G, F.bid);
                EpiSwiGLU E{HID}; pg8::gemm_phase(F.lds, g, S, E);
                filler_tasks(F, slot_begin(l, 2), slot_end(l, 2), S.nwg); }
            PH_END;
            if (PH_RUN && SITE(15)) { FRESH; pg8::Gemm g{HID, (const half_t*)(ws + WS_WFO) + (size_t)(l * 2 + 1) * D * DFF, MR, D, DFF}; pg8::StaticOrder S; S.init(SEQ, D, DFF, F.G, F.bid, need_ctx ? FFO_SLICE : 0);
                EpiResid E{ws, mod_lat + 8 * D, 0.5f}; pg8::gemm_phase(F.lds, g, S, E);
                if (l < DEPTH - 1 && N_LAUNCH_MODE == 0) filler_mod(F, l + 1, NT_MOD / 2, NT_MOD, S.nwg + S.nslu); }
            PH_END;
        }
    }
    if (PH_RUN && SITE(16)) { FRESH; final_norm_phase(F); }
    PH_END;
#undef PH_RUN
#undef PH_END
#undef MODP
#undef U
#undef HID
#undef Y
#undef mod_lat
#undef mod_ctx
#undef ng
}

extern "C" void kernel_launch(void* const* d_in, const int* in_sizes, int n_in, void* d_out, int out_size, void* d_ws, size_t ws_size, hipStream_t stream) {
    static int grid = 0;
    if (grid == 0) {
        if (n_in != 18 || out_size != SEQ * D || ws_size < WS_END) { fprintf(stderr, "kernel_launch: unexpected problem (n_in %d out %d ws %zu need %zu)\n", n_in, out_size, ws_size, (size_t)WS_END); grid = -1; return; }
        int dev = 0, cus = 0, per_cu = 0;
        if (hipGetDevice(&dev) != hipSuccess || hipDeviceGetAttribute(&cus, hipDeviceAttributeMultiprocessorCount, dev) != hipSuccess) { grid = -1; return; }
        if (hipFuncSetAttribute((const void*)trunk_fwd, hipFuncAttributeMaxDynamicSharedMemorySize, LDS_BYTES) != hipSuccess) { fprintf(stderr, "kernel_launch: hipFuncSetAttribute failed\n"); grid = -1; return; }
        if (hipOccupancyMaxActiveBlocksPerMultiprocessor(&per_cu, (const void*)trunk_fwd, NTHREADS, LDS_BYTES) != hipSuccess || per_cu < 1) { fprintf(stderr, "kernel_launch: occupancy query says %d\n", per_cu); }
        (void)hipGetLastError();
        grid = cus;
    }
    if (grid < 0) return;
    (void)hipMemsetAsync(d_ws, 0, WS_ZERO_END, stream);
    Args a{};
    for (int i = 0; i < 18; ++i) a.in[i] = (const float*)d_in[i];
    a.out = (float*)d_out; a.ws = (unsigned char*)d_ws;
#if N_LAUNCH_MODE == 0
    a.ph_lo = 0; a.ph_hi = NPHASES;
    hipLaunchKernelGGL(trunk_fwd, dim3(grid), dim3(NTHREADS), LDS_BYTES, stream, a);
#else
    for (int p = 0; p < NPHASES; ++p) { a.ph_lo = p; a.ph_hi = p + 1; hipLaunchKernelGGL(trunk_fwd, dim3(grid), dim3(NTHREADS), LDS_BYTES, stream, a); }
#endif
}
```

```cpp
#include <hip/hip_runtime.h>
#include <cstdio>
#include <cstdint>

#ifndef N_LAUNCH_MODE
#define N_LAUNCH_MODE 0
#endif
#ifndef NAIVE_GEMM
#define NAIVE_GEMM 0
#endif

#define LAS __attribute__((address_space(3)))
typedef _Float16 half_t;
typedef _Float16 h2 __attribute__((ext_vector_type(2)));
typedef _Float16 h4 __attribute__((ext_vector_type(4)));
typedef _Float16 h8 __attribute__((ext_vector_type(8)));
typedef float f32x2 __attribute__((ext_vector_type(2)));
typedef float f32x4 __attribute__((ext_vector_type(4)));
typedef float f32x16 __attribute__((ext_vector_type(16)));
typedef unsigned u32x4 __attribute__((ext_vector_type(4)));

constexpr int D = 2048, SEQ = 8192, NCTX = 256, MR = SEQ + NCTX, DFF = 5632, NFFIN = 2 * DFF, NEV = 8192, NQKV = 3072, DEPTH = 4;
constexpr int MODN = 9 * D;
constexpr float EPS = 1e-6f;
constexpr float LOG2E = 1.4426950408889634f;
constexpr float QSCALE = 0.08838834764831845f * 1.4426950408889634f;
constexpr int NWAVES = 8, NTHREADS = 512;
constexpr int LDS_BYTES = 147456;

constexpr size_t al256(size_t x) { return (x + 255) & ~(size_t)255; }
constexpr size_t WS_BAR = 0;
constexpr size_t WS_ZERO_END = 16384;
constexpr size_t WS_MOD = 16384;
constexpr size_t WS_LB = al256(WS_MOD + (size_t)DEPTH * 2 * MODN * 4);
constexpr size_t WS_ROPE = WS_LB + 2 * 2 * 1024 * 4;
constexpr size_t WS_H = al256(WS_ROPE + 2 * 128 * 32 * 4);
constexpr size_t WS_U = WS_H + (size_t)MR * D * 2;
constexpr size_t WS_HID = WS_U + (size_t)MR * D * 2;
constexpr size_t WS_Y = WS_HID + (size_t)MR * DFF * 2;
constexpr size_t WS_P0 = WS_Y + (size_t)MR * D * 2;
constexpr size_t WS_QA = WS_P0;
constexpr size_t WS_KA = WS_QA + (size_t)MR * 1024 * 2;
constexpr size_t WS_VTA = WS_KA + (size_t)MR * 1024 * 2;
constexpr size_t WS_QB = WS_VTA + (size_t)MR * 1024 * 2;
constexpr size_t WS_LF = WS_QB + (size_t)MR * 1024 * 2;
constexpr size_t WS_VTB = WS_LF + (size_t)2 * MR * 1024 * 2;
constexpr size_t WS_GS = WS_VTB + (size_t)MR * 1024 * 2;
constexpr size_t WS_KH = WS_GS + (size_t)MR * 1024 * 2;
constexpr size_t WS_PE_END = WS_KH + (size_t)2 * MR * 1024 * 2;
constexpr size_t WS_Q = WS_P0;
constexpr size_t WS_K = WS_Q + (size_t)MR * 2048 * 2;
constexpr size_t WS_VT = WS_K + (size_t)MR * 512 * 2;
constexpr size_t WS_VROW = WS_PE_END;
constexpr size_t WS_OG = WS_VROW + (size_t)MR * 1024 * 2;
constexpr size_t WS_US = WS_OG + (size_t)2 * MR * 1024 * 4;
constexpr size_t WS_DEC = WS_US + (size_t)2 * 132 * 8 * 128 * 128 * 2;
constexpr size_t WS_PART = al256(WS_DEC + (size_t)2 * 132 * 8 * 128 * 4);
constexpr size_t WS_W = WS_PART + (size_t)22 * 256 * 2048 * 4;
constexpr size_t WS_WFI = WS_W;
constexpr size_t WS_WFO = WS_WFI + (size_t)8 * NFFIN * D * 2;
constexpr size_t WS_WIE = WS_WFO + (size_t)8 * D * DFF * 2;
constexpr size_t WS_WOE = WS_WIE + (size_t)2 * NEV * D * 2;
constexpr size_t WS_WQKV = WS_WOE + (size_t)2 * D * D * 2;
constexpr size_t WS_WOO = WS_WQKV + (size_t)2 * NQKV * D * 2;
constexpr size_t WS_MODPART = WS_WOO + (size_t)2 * D * D * 2;
constexpr size_t WS_END = WS_MODPART + (size_t)DEPTH * 32 * 2 * MODN * 4;

#define XB_TMO      128
#define XB_XCNT(j)  (256  + 64 * (j))
#define XB_XSUB(j)  (1280 + 64 * (j))
#define XB_XGEN(j)  (2304 + 64 * (j))
#define XB_TOP      3328
#define XB_TOPGEN   3392
#define XCD_BAR_WORDS 3456
#define XB_SPIN_CAP (1u << 22)
__device__ __forceinline__ unsigned xb_ld(unsigned* p)              { return __hip_atomic_load(p, __ATOMIC_RELAXED, __HIP_MEMORY_SCOPE_AGENT); }
__device__ __forceinline__ unsigned xb_add(unsigned* p, unsigned v) { return __hip_atomic_fetch_add(p, v, __ATOMIC_RELAXED, __HIP_MEMORY_SCOPE_AGENT); }
__device__ __forceinline__ unsigned xb_xcc_id() { return (unsigned)__builtin_amdgcn_s_getreg((3 << 11) | 20) & 0xFu; }
#define XB_SPIN(cond, bar) do { unsigned _sp = 0; while (cond) { __builtin_amdgcn_s_sleep(1); \
    if ((++_sp & 255u) == 0u) { if (xb_ld(&(bar)[XB_TMO])) break; if (_sp > XB_SPIN_CAP) { atomicAdd(&(bar)[XB_TMO], 1u); break; } } } } while (0)
struct XcdBarrier { unsigned* bar; unsigned x; volatile LAS unsigned* st; };
__device__ __forceinline__ XcdBarrier xcd_barrier_post(unsigned* bar, volatile LAS unsigned* st) {
    XcdBarrier b; b.bar = bar; b.x = xb_xcc_id(); b.st = st;
    if (threadIdx.x == 0) (void)xb_add(&bar[XB_XCNT(b.x)], 1u);
    return b;
}
__device__ __forceinline__ void xcd_barrier_complete(unsigned* bar, unsigned x, unsigned& nloc, unsigned& nx) {
    const unsigned G = gridDim.x * gridDim.y * gridDim.z;
    unsigned sum, cnt, mine, sp = 0u;
    for (;;) {
        sum = 0u; cnt = 0u; mine = 0u;
#pragma unroll
        for (unsigned j = 0; j < 16; ++j) { const unsigned c = xb_ld(&bar[XB_XCNT(j)]); sum += c; cnt += (c > 0u) ? 1u : 0u; mine = (j == x) ? c : mine; }
        if (sum == G) break;
        __builtin_amdgcn_s_sleep(1);
        if ((++sp & 255u) == 0u) { if (xb_ld(&bar[XB_TMO])) break; if (sp > XB_SPIN_CAP) { atomicAdd(&bar[XB_TMO], 1u); break; } }
    }
    nloc = mine > 0u ? mine : 1u; nx = cnt > 0u ? cnt : 1u;
}
__device__ __forceinline__ void xcd_barrier(const XcdBarrier& b) {
    asm volatile("s_waitcnt vmcnt(0)" ::: "memory");
    __syncthreads();
    if (threadIdx.x == 0) {
        unsigned* bar = b.bar;
        __builtin_amdgcn_s_waitcnt(0);
        unsigned nloc = b.st[0], nx = b.st[1];
        if (nloc == 0u) { xcd_barrier_complete(bar, b.x, nloc, nx); b.st[0] = nloc; b.st[1] = nx; }
        const unsigned old = xb_add(&bar[XB_XSUB(b.x)], 1u);
        const unsigned gen = old / nloc;
        if (old + 1u == (gen + 1u) * nloc) {
            __builtin_amdgcn_fence(__ATOMIC_RELEASE, "agent");
            asm volatile("s_waitcnt vmcnt(0)" ::: "memory");
            const unsigned og = xb_add(&bar[XB_TOP], 1u);
            const unsigned tg = og / nx;
            if (og + 1u == (tg + 1u) * nx) xb_add(&bar[XB_TOPGEN], 1u);
            else XB_SPIN(xb_ld(&bar[XB_TOPGEN]) == tg, bar);
            __builtin_amdgcn_fence(__ATOMIC_ACQUIRE, "agent");
            xb_add(&bar[XB_XGEN(b.x)], 1u);
            asm volatile("s_waitcnt vmcnt(0)" ::: "memory");
        } else {
            XB_SPIN(xb_ld(&bar[XB_XGEN(b.x)]) == gen, bar);
            __builtin_amdgcn_fence(__ATOMIC_ACQUIRE, "agent");
            asm volatile("s_waitcnt vmcnt(0)" ::: "memory");
        }
    }
    __syncthreads();
}

__device__ __forceinline__ float wave_sum(float v) {
#pragma unroll
    for (int o = 32; o >= 1; o >>= 1) v += __shfl_xor(v, o);
    return v;
}
__device__ __forceinline__ float wave_max(float v) {
#pragma unroll
    for (int o = 32; o >= 1; o >>= 1) v = fmaxf(v, __shfl_xor(v, o));
    return v;
}
__device__ __forceinline__ float fast_exp2(float x) { return __builtin_amdgcn_exp2f(x); }
__device__ __forceinline__ float silu_f(float g) { return g * __builtin_amdgcn_rcpf(1.0f + fast_exp2(-g * LOG2E)); }
__device__ __forceinline__ h8 pack8(const f32x4 a, const f32x4 b) {
    h8 o; o[0] = (half_t)a[0]; o[1] = (half_t)a[1]; o[2] = (half_t)a[2]; o[3] = (half_t)a[3]; o[4] = (half_t)b[0]; o[5] = (half_t)b[1]; o[6] = (half_t)b[2]; o[7] = (half_t)b[3]; return o;
}

#ifndef DROP_FFN
#define DROP_FFN 5
#endif
#ifndef DROP_MIX
#define DROP_MIX 3
#endif
typedef unsigned u32x2 __attribute__((ext_vector_type(2)));
__host__ __device__ constexpr unsigned opr_add(int drop) { return ((1u << drop) >> 1) * 0x00010001u; }
__host__ __device__ constexpr unsigned opr_mask(int drop) { return ~(((1u << drop) - 1u) * 0x00010001u); }
__device__ __forceinline__ h8 opround(const h8 v, int drop) { u32x4 u = __builtin_bit_cast(u32x4, v); u = (u + opr_add(drop)) & opr_mask(drop); return __builtin_bit_cast(h8, u); }
__device__ __forceinline__ h4 opround(const h4 v, int drop) { u32x2 u = __builtin_bit_cast(u32x2, v); u = (u + opr_add(drop)) & opr_mask(drop); return __builtin_bit_cast(h4, u); }

struct Frame {
    LAS unsigned char* lds; int tid, lane, wave, G, bid;
    const float* in[18]; float* out; unsigned char* ws;
};

namespace pg8 {
constexpr int BM = 256, BK = 64, HALF = 128, HTB = HALF * BK * 2, STAGE_BYTES = 8 * HTB, NXCD = 8, WGM = 8;
__host__ __device__ __forceinline__ int lds_byte(int r, int c) { const int st = (r >> 4) * 2 + (c >> 5), rr = r & 15, cc = c & 31, ob = rr * 64 + cc * 2; return st * 1024 + (ob ^ (((ob >> 9) & 1) << 5)); }
__host__ __device__ __forceinline__ void stage_rc(int b, int& R, int& C) { const int st = b / 1024, sb = b % 1024, swz = sb ^ (((sb >> 9) & 1) << 5); R = (st >> 1) * 16 + swz / 64; C = (st & 1) * 32 + (swz % 64) / 2; }
__host__ __device__ __forceinline__ int perm32(int rho) { const int n = rho >> 4, i = rho & 15; return 8 * (i >> 2) + 4 * n + (i & 3); }
struct Unit { int pm, pn, kt0, nkt, part; };
struct Gemm { const half_t* A; const half_t* Bt; int M, N, K; };
struct StaticOrder {
    int nM, nN, nwg, G, c, nkt, slice_kt, nslu;
    __host__ __device__ __forceinline__ void init(int M, int N, int K, int G_, int c_, int slice_kt_ = 0) { nM = M / BM; nN = N / BM; nwg = nM * nN; G = G_; c = c_; nkt = K / BK; slice_kt = slice_kt_; nslu = slice_kt_ ? (nkt / slice_kt_) * nN : 0; }
    __host__ __device__ __forceinline__ bool next(int i, Unit& u) const {
        const int L = i * G + c, j = L - nwg; const bool mainu = L < nwg;
        if (!mainu && j >= nslu) return false;
        int wgid = mainu ? L : 0; { const int q = nwg / NXCD, r = nwg % NXCD, xcd = wgid % NXCD, off = wgid / NXCD; wgid = (xcd < r ? xcd * (q + 1) : r * (q + 1) + (xcd - r) * q) + off; }
        const int nig = WGM * nN, gid = wgid / nig, fm = gid * WGM, gsz = (nM - fm) < WGM ? (nM - fm) : WGM;
        const int pm_m = fm + ((wgid % nig) % gsz), pn_m = (wgid % nig) / gsz, jj = mainu ? 0 : j, ks = jj / nN;
        u.pm = mainu ? pm_m : SEQ / BM; u.pn = mainu ? pn_m : jj - ks * nN; u.part = mainu ? 0 : 1 + ks; u.kt0 = mainu ? 0 : ks * slice_kt; u.nkt = mainu ? nkt : slice_kt;
        return true;
    }
};
#if !NAIVE_GEMM
template <class Epi, class Sched>
__device__ __forceinline__ void gemm_phase(LAS unsigned char* lds, const Gemm g, const Sched& S, const Epi& E) {
    int tid = threadIdx.x; asm volatile("" : "+v"(tid));
    const int wid = __builtin_amdgcn_readfirstlane(tid >> 6), lane = tid & 63, wr = wid >> 2, wc = wid & 3, fr = lane & 15, fq = lane >> 4;
    const int K = g.K;
    unsigned voffA[2], voffB[2];
#pragma unroll
    for (int i = 0; i < 2; ++i) { int R, C; stage_rc(tid * 16 + i * 8192, R, C); const int Rb = (R & ~31) + perm32(R & 31);
        voffA[i] = (unsigned)(R * K + C) * 2u; voffB[i] = (unsigned)(Rb * K + C) * 2u; }
    const size_t kstep = (size_t)(BK * 2);
    const size_t hstep = (size_t)HALF * K * 2;
    const size_t tstep = 2 * hstep;
    const unsigned ldsw = (unsigned)wid * 1024u;
    const int aoff = lds_byte(wr * 64 + fr, fq * 8), boff = lds_byte(wc * 32 + fr, fq * 8);
#define PG8_SA(b, h) (((b) * 2 + (h)) * HTB)
#define PG8_SB(b, h) ((4 + (b) * 2 + (h)) * HTB)
#define PG8_STAGE(bufoff, gbase, voff) do { _Pragma("unroll") for (int _i = 0; _i < 2; ++_i) \
        __builtin_amdgcn_global_load_lds((const unsigned*)((const char*)(gbase) + (voff)[_i]), (LAS unsigned*)(lds + (bufoff) + ldsw + _i * 8192), 16, 0, 0); } while (0)
#define PG8_LDA(dst, b, h) do { _Pragma("unroll") for (int m = 0; m < 4; ++m) _Pragma("unroll") for (int k = 0; k < 2; ++k) dst[m][k] = *(const LAS h8*)(lds + PG8_SA(b, h) + aoff + m * 2048 + k * 1024); } while (0)
#define PG8_LDB(dst, b, h) do { _Pragma("unroll") for (int n = 0; n < 2; ++n) _Pragma("unroll") for (int k = 0; k < 2; ++k) dst[n][k] = *(const LAS h8*)(lds + PG8_SB(b, h) + boff + n * 2048 + k * 1024); } while (0)
#define PG8_MMA(ai, bj, At, Bt) do { __builtin_amdgcn_s_setprio(1); _Pragma("unroll") for (int m = 0; m < 4; ++m) _Pragma("unroll") for (int n = 0; n < 2; ++n) _Pragma("unroll") for (int k = 0; k < 2; ++k) \
        acc[ai][bj][m][n] = __builtin_amdgcn_mfma_f32_16x16x32_f16(Bt[n][k], At[m][k], acc[ai][bj][m][n], 0, 0, 0); __builtin_amdgcn_s_setprio(0); } while (0)
#define PG8_WAIT_V(n) asm volatile("s_waitcnt vmcnt(" #n ")" ::: "memory")
#define PG8_WAIT_L(n) asm volatile("s_waitcnt lgkmcnt(" #n ")" ::: "memory")
#define PG8_BAR __builtin_amdgcn_s_barrier()
#define PG8_SCHED __builtin_amdgcn_sched_barrier(0)
    Unit cur, nxt; int ui = 0;
    if (!S.next(0, cur)) return;
    f32x4 acc[2][2][4][2];
#pragma unroll
    for (int a = 0; a < 2; ++a)
#pragma unroll
        for (int b = 0; b < 2; ++b)
#pragma unroll
            for (int m = 0; m < 4; ++m)
#pragma unroll
                for (int n = 0; n < 2; ++n) acc[a][b][m][n] = (f32x4){0.f, 0.f, 0.f, 0.f};
    h8 At[4][2], B0[2][2], B1[2][2];
    const char* cA = (const char*)g.A + (size_t)cur.pm * tstep + (size_t)cur.kt0 * kstep; const char* cB = (const char*)g.Bt + (size_t)cur.pn * tstep + (size_t)cur.kt0 * kstep;
    PG8_STAGE(PG8_SB(0, 0), cB, voffB); PG8_STAGE(PG8_SB(0, 1), cB + hstep, voffB); PG8_STAGE(PG8_SA(0, 0), cA, voffA); PG8_STAGE(PG8_SA(0, 1), cA + hstep, voffA);
    if (wr == 1) PG8_BAR;
    PG8_WAIT_V(2); PG8_BAR;
    PG8_STAGE(PG8_SB(1, 0), cB + kstep, voffB); PG8_STAGE(PG8_SA(1, 0), cA + kstep, voffA); PG8_STAGE(PG8_SB(1, 1), cB + hstep + kstep, voffB);
    PG8_WAIT_V(6); PG8_BAR;
    for (;;) {
        const bool has_next = S.next(ui + 1, nxt);
        const char* nA = has_next ? (const char*)g.A + (size_t)nxt.pm * tstep + (size_t)nxt.kt0 * kstep : cA; const char* nB = has_next ? (const char*)g.Bt + (size_t)nxt.pn * tstep + (size_t)nxt.kt0 * kstep : cB;
        const int nt = cur.nkt;
        for (int t = 0; t < nt; t += 2) {
            const bool last = (t == nt - 2);
            const char* a1 = cA + (size_t)(t + 1) * kstep;
            const char* a2 = last ? nA : cA + (size_t)(t + 2) * kstep; const char* b2 = last ? nB : cB + (size_t)(t + 2) * kstep;
            const char* a3 = a2 + kstep; const char* b3 = b2 + kstep;
            PG8_LDB(B0, 0, 0); PG8_LDB(B1, 0, 1); PG8_SCHED; PG8_LDA(At, 0, 0); PG8_STAGE(PG8_SA(1, 1), a1 + hstep, voffA);
            PG8_WAIT_V(8); PG8_WAIT_L(0); PG8_BAR; PG8_MMA(0, 0, At, B0); PG8_MMA(0, 1, At, B1); PG8_BAR; PG8_SCHED;
            PG8_LDA(At, 0, 1); PG8_STAGE(PG8_SB(0, 0), b2, voffB); PG8_STAGE(PG8_SB(0, 1), b2 + hstep, voffB); PG8_STAGE(PG8_SA(0, 0), a2, voffA);
            PG8_WAIT_V(8); PG8_WAIT_L(0); PG8_BAR; PG8_MMA(1, 0, At, B0); PG8_MMA(1, 1, At, B1); PG8_BAR; PG8_SCHED;
            PG8_LDB(B0, 1, 0); PG8_LDB(B1, 1, 1); PG8_SCHED; PG8_LDA(At, 1, 0); PG8_STAGE(PG8_SA(0, 1), a2 + hstep, voffA);
            PG8_WAIT_V(8); PG8_WAIT_L(0); PG8_BAR; PG8_MMA(0, 0, At, B0); PG8_MMA(0, 1, At, B1); PG8_BAR; PG8_SCHED;
            PG8_LDA(At, 1, 1); PG8_STAGE(PG8_SB(1, 0), b3, voffB); PG8_STAGE(PG8_SB(1, 1), b3 + hstep, voffB); PG8_STAGE(PG8_SA(1, 0), a3, voffA);
            PG8_WAIT_V(8); PG8_WAIT_L(0); PG8_BAR; PG8_MMA(1, 0, At, B0); PG8_MMA(1, 1, At, B1); PG8_BAR; PG8_SCHED;
        }
        if (wr == 0) PG8_BAR;
        E(acc, cur, wr, wc, fr, fq);
        if (!has_next) break;
#pragma unroll
        for (int a = 0; a < 2; ++a)
#pragma unroll
            for (int b = 0; b < 2; ++b)
#pragma unroll
                for (int m = 0; m < 4; ++m)
#pragma unroll
                    for (int n = 0; n < 2; ++n) acc[a][b][m][n] = (f32x4){0.f, 0.f, 0.f, 0.f};
        cur = nxt; cA = nA; cB = nB; ++ui;
        if (wr == 1) PG8_BAR;
    }
    PG8_WAIT_V(0);
    PG8_BAR;
#undef PG8_SA
#undef PG8_SB
#undef PG8_STAGE
#undef PG8_LDA
#undef PG8_LDB
#undef PG8_MMA
#undef PG8_WAIT_V
#undef PG8_WAIT_L
#undef PG8_BAR
#undef PG8_SCHED
}
#else
template <class Epi, class Sched>
__device__ __forceinline__ void gemm_phase(LAS unsigned char* lds, const Gemm g, const Sched& S, const Epi& E) {
    const int tid = threadIdx.x, wid = tid >> 6, lane = tid & 63, wr = wid >> 2, wc = wid & 3, fr = lane & 15, fq = lane >> 4;
    const int K = g.K; Unit u;
    for (int ui = 0; S.next(ui, u); ++ui) {
        f32x4 acc[2][2][4][2];
#pragma unroll
        for (int ai = 0; ai < 2; ++ai)
#pragma unroll
        for (int bj = 0; bj < 2; ++bj)
#pragma unroll
        for (int m = 0; m < 4; ++m)
#pragma unroll
        for (int n = 0; n < 2; ++n) {
            f32x4 s = {0.f, 0.f, 0.f, 0.f};
            const half_t* a = g.A + (size_t)(u.pm * 256 + ai * 128 + wr * 64 + m * 16 + fr) * K;
            const half_t* b = g.Bt + (size_t)(u.pn * 256 + bj * 128 + wc * 32 + fq * 8 + n * 4) * K;
            for (int k = u.kt0 * 64; k < (u.kt0 + u.nkt) * 64; k += 8) { const h8 av = *(const h8*)(a + k);
                for (int r = 0; r < 4; ++r) { const h8 bv = *(const h8*)(b + (size_t)r * K + k); float t = s[r];
                    for (int j = 0; j < 8; ++j) t += (float)av[j] * (float)bv[j];
                    s[r] = t; } }
            acc[ai][bj][m][n] = s; }
        E(acc, u, wr, wc, fr, fq);
    }
}
#endif
}

struct EpiSwiGLU {
    half_t* hid;
    __device__ __forceinline__ void operator()(const f32x4 (&acc)[2][2][4][2], const pg8::Unit& u, int wr, int wc, int fr, int fq) const {
        asm volatile("" : "+v"(fr), "+v"(fq));
        const int row0 = u.pm * 256 + wr * 64 + fr, col0 = u.pn * 128 + wc * 32 + 8 * fq;
#pragma unroll
        for (int ai = 0; ai < 2; ++ai)
#pragma unroll
            for (int m = 0; m < 4; ++m) {
                const f32x4 g0 = acc[ai][0][m][0], g1 = acc[ai][0][m][1], u0 = acc[ai][1][m][0], u1 = acc[ai][1][m][1];
                f32x4 o0, o1;
#pragma unroll
                for (int j = 0; j < 4; ++j) { o0[j] = silu_f(g0[j]) * u0[j]; o1[j] = silu_f(g1[j]) * u1[j]; }
                *(h8*)(hid + (size_t)(row0 + ai * 128 + m * 16) * DFF + col0) = opround(pack8(o0, o1), DROP_FFN);
            }
    }
};
struct EpiResid {
    unsigned char* ws; const float* coef_lat; float scale;
    __device__ __forceinline__ void operator()(const f32x4 (&acc)[2][2][4][2], const pg8::Unit& u, int wr, int wc, int fr, int fq) const {
        asm volatile("" : "+v"(fr), "+v"(fq));
        const int col0 = u.pn * 256 + wc * 32 + 8 * fq;
        const float* coef = coef_lat + ((u.pm == SEQ / 256) ? MODN : 0) + col0;
        const f32x4 c00 = *(const f32x4*)(coef) * scale, c01 = *(const f32x4*)(coef + 4) * scale, c10 = *(const f32x4*)(coef + 128) * scale, c11 = *(const f32x4*)(coef + 132) * scale;
        if (u.part) {
            float* base = (float*)(ws + WS_PART) + (size_t)(u.part - 1) * NCTX * D + (size_t)(wr * 64 + fr) * D + col0;
#pragma unroll
            for (int ai = 0; ai < 2; ++ai)
#pragma unroll
                for (int m = 0; m < 4; ++m) { float* rowp = base + (size_t)(ai * 128 + m * 16) * D;
                    *(f32x4*)(rowp) = c00 * acc[ai][0][m][0]; *(f32x4*)(rowp + 4) = c01 * acc[ai][0][m][1]; *(f32x4*)(rowp + 128) = c10 * acc[ai][1][m][0]; *(f32x4*)(rowp + 132) = c11 * acc[ai][1][m][1]; }
        } else {
            half_t* base = (half_t*)(ws + WS_H) + (size_t)(u.pm * 256 + wr * 64 + fr) * D + col0;
#pragma unroll
            for (int ai = 0; ai < 2; ++ai)
#pragma unroll
                for (int m = 0; m < 4; ++m) { half_t* rowp = base + (size_t)(ai * 128 + m * 16) * D;
                    const h8 h0 = *(const h8*)rowp, h1 = *(const h8*)(rowp + 128); f32x4 v00, v01, v10, v11;
#pragma unroll
                    for (int j = 0; j < 4; ++j) { v00[j] = (float)h0[j]; v01[j] = (float)h0[4 + j]; v10[j] = (float)h1[j]; v11[j] = (float)h1[4 + j]; }
                    v00 += c00 * acc[ai][0][m][0]; v01 += c01 * acc[ai][0][m][1]; v10 += c10 * acc[ai][1][m][0]; v11 += c11 * acc[ai][1][m][1];
                    *(h8*)rowp = pack8(v00, v01); *(h8*)(rowp + 128) = pack8(v10, v11); }
        }
    }
};
__device__ __forceinline__ void forget_gates(float fx, float lb, float& logf_, float& k_) {
    const float e = fast_exp2(-fmaxf(fx, -80.f) * LOG2E), r = __builtin_amdgcn_rcpf(1.0f + e);
    logf_ = __builtin_amdgcn_logf(lb + (1.f - lb) * r) * 0.6931471805599453f;
    k_ = (1.f - lb) * e * r;
}
struct EpiEven {
    half_t *QA, *KA, *VTA, *QB, *VTB, *GS, *KH; half_t* LF; const float* lb; const float* hg_norm_g;
    __device__ __forceinline__ void operator()(const f32x4 (&acc)[2][2][4][2], const pg8::Unit& u, int wr, int wc, int fr, int fq) const {
        asm volatile("" : "+v"(fr), "+v"(fq));
        const int row0 = u.pm * 256 + wr * 64 + fr, type = u.pn >> 2, cb0 = (u.pn & 3) * 256 + wc * 32 + 8 * fq;
#ifndef EV_MASK
#define EV_MASK 15
#endif
        if ((EV_MASK & 1) && (type == 0 || type == 1 || type == 3)) {
            half_t* dst = type == 0 ? QA : (type == 1 ? KA : QB); const float sc = type == 0 ? QSCALE : 1.0f;
#pragma unroll
            for (int ai = 0; ai < 2; ++ai)
#pragma unroll
                for (int m = 0; m < 4; ++m)
#pragma unroll
                    for (int bj = 0; bj < 2; ++bj)
                        *(h8*)(dst + (size_t)(row0 + ai * 128 + m * 16) * 1024 + cb0 + bj * 128) = pack8(acc[ai][bj][m][0] * sc, acc[ai][bj][m][1] * sc);
        } else if ((EV_MASK & 2) && (type == 2 || type == 6)) {
            half_t* dst = type == 2 ? VTA : VTB;
#pragma unroll
            for (int bj = 0; bj < 2; ++bj)
#pragma unroll
                for (int n = 0; n < 2; ++n)
#pragma unroll
                    for (int j = 0; j < 4; ++j) { half_t* cp = dst + (size_t)(cb0 + bj * 128 + 4 * n + j) * MR + row0;
#pragma unroll
                        for (int ai = 0; ai < 2; ++ai)
#pragma unroll
                            for (int m = 0; m < 4; ++m) cp[ai * 128 + m * 16] = (half_t)acc[ai][bj][m][n][j];
                        asm volatile("" ::: "memory"); }
        } else if ((EV_MASK & 4) && (type == 4 || type == 5)) {
            half_t* dst = LF + (size_t)(type - 4) * MR * 1024; half_t* dk_ = KH + (size_t)(type - 4) * MR * 1024; const float* lbv = lb + (type - 4) * 2048;
#pragma unroll
            for (int bj = 0; bj < 2; ++bj) { const f32x4 l0 = *(const f32x4*)(lbv + cb0 + bj * 128), l1 = *(const f32x4*)(lbv + cb0 + bj * 128 + 4);
#pragma unroll
                for (int ai = 0; ai < 2; ++ai)
#pragma unroll
                    for (int m = 0; m < 4; ++m) { f32x4 o0, o1, k0, k1; const f32x4 a0 = acc[ai][bj][m][0], a1 = acc[ai][bj][m][1];
#pragma unroll
                        for (int j = 0; j < 4; ++j) { float lo_, ko_; forget_gates(a0[j], l0[j], lo_, ko_); o0[j] = lo_; k0[j] = ko_; forget_gates(a1[j], l1[j], lo_, ko_); o1[j] = lo_; k1[j] = ko_; }
                        const size_t o = (size_t)(row0 + ai * 128 + m * 16) * 1024 + cb0 + bj * 128;
                        *(h8*)(dst + o) = pack8(o0, o1); (void)dk_; (void)k0; (void)k1; } }
        } else if (EV_MASK & 8) {
#pragma unroll
            for (int bj = 0; bj < 2; ++bj) { const f32x4 g0 = *(const f32x4*)(hg_norm_g + cb0 + bj * 128), g1 = *(const f32x4*)(hg_norm_g + cb0 + bj * 128 + 4);
#pragma unroll
                for (int ai = 0; ai < 2; ++ai)
#pragma unroll
                    for (int m = 0; m < 4; ++m) { f32x4 o0, o1; const f32x4 a0 = acc[ai][bj][m][0], a1 = acc[ai][bj][m][1];
#pragma unroll
                        for (int j = 0; j < 4; ++j) { o0[j] = g0[j] * silu_f(a0[j]); o1[j] = g1[j] * silu_f(a1[j]); }
                        *(h8*)(GS + (size_t)(row0 + ai * 128 + m * 16) * 1024 + cb0 + bj * 128) = pack8(o0, o1); } }
        }
    }
};
struct EpiOdd {
    half_t *Q, *Kc, *VT; const float* ropec; const float* ropes;
    __device__ __forceinline__ void operator()(const f32x4 (&acc)[2][2][4][2], const pg8::Unit& u, int wr, int wc, int fr, int fq) const {
        asm volatile("" : "+v"(fr), "+v"(fq));
        const int row0 = u.pm * 256 + wr * 64 + fr;
        if (u.pn < 10) {
            const bool isq = u.pn < 8; const int a = wc >> 1, p = wc & 1, d1 = 64 * p + 8 * fq;
            const int head = isq ? 2 * u.pn + a : 2 * (u.pn - 8) + a; half_t* dst = isq ? Q : Kc; const int pitch = isq ? 2048 : 512; const float sc = isq ? QSCALE : 1.0f;
            const bool lat = u.pm < SEQ / 256;
#pragma unroll
            for (int ai = 0; ai < 2; ++ai)
#pragma unroll
                for (int m = 0; m < 4; ++m) { const int row = row0 + ai * 128 + m * 16;
                    f32x4 x10 = acc[ai][0][m][0], x11 = acc[ai][0][m][1], x20 = acc[ai][1][m][0], x21 = acc[ai][1][m][1];
                    if (lat) { const int pos = p == 0 ? (row >> 6) : (row & 63);
                        const f32x4 c0 = *(const f32x4*)(ropec + pos * 32 + 8 * fq), c1 = *(const f32x4*)(ropec + pos * 32 + 8 * fq + 4);
                        const f32x4 s0 = *(const f32x4*)(ropes + pos * 32 + 8 * fq), s1 = *(const f32x4*)(ropes + pos * 32 + 8 * fq + 4);
                        const f32x4 y10 = x10 * c0 - x20 * s0, y11 = x11 * c1 - x21 * s1, y20 = x10 * s0 + x20 * c0, y21 = x11 * s1 + x21 * c1;
                        x10 = y10; x11 = y11; x20 = y20; x21 = y21; }
                    half_t* o = dst + (size_t)row * pitch + head * 128 + d1;
                    *(h8*)o = pack8(x10 * sc, x11 * sc); *(h8*)(o + 32) = pack8(x20 * sc, x21 * sc); }
        } else {
            const int cb0 = (u.pn - 10) * 256 + wc * 32 + 8 * fq;
#pragma unroll
            for (int bj = 0; bj < 2; ++bj)
#pragma unroll
                for (int n = 0; n < 2; ++n)
#pragma unroll
                    for (int j = 0; j < 4; ++j) { half_t* cp = VT + (size_t)(cb0 + bj * 128 + 4 * n + j) * MR + row0;
#pragma unroll
                        for (int ai = 0; ai < 2; ++ai)
#pragma unroll
                            for (int m = 0; m < 4; ++m) cp[ai * 128 + m * 16] = (half_t)acc[ai][bj][m][n][j];
                        asm volatile("" ::: "memory"); }
        }
    }
};

template <int PERM> __device__ __forceinline__ int dst_row(int n) {
    if (PERM == 1) {
        return n < DFF ? 256 * (n >> 7) + (n & 127) : 256 * ((n - DFF) >> 7) + 128 + ((n - DFF) & 127);
    } else if (PERM == 2) {
        if (n >= 2560) return n;
        const int T = n >> 8, w = n & 255, a = w >> 7, d = w & 127, p = d >> 6, x = (d >> 5) & 1, j = d & 31;
        return 256 * T + 128 * x + 64 * a + 32 * p + j;
    }
    return n;
}
constexpr int MOD_ROWS = 64, NT_MOD = (D / MOD_ROWS) * (MODN / 256);
constexpr int I_FI = (D / 64) * (NFFIN / 32), I_FO = (DFF / 64) * (D / 32), I_IE = (D / 64) * (NEV / 32), I_DD = (D / 64) * (D / 32), I_QKV = (D / 64) * (NQKV / 32);
constexpr int FILL_CAP_FF = 136, FILL_CAP_IE = 88, FILL_CAP_QKV = 136;
constexpr int LT_E = 2 * I_FI + 2 * I_FO + I_IE + I_DD, LT_O = 2 * I_FI + 2 * I_FO + I_QKV + I_DD, CV_TOTAL = 2 * (LT_E + LT_O);
constexpr int CV_PRO = 15424 + 256;
__host__ __device__ constexpr int cv_layer_begin(int L) { return (L >> 1) * (LT_E + LT_O) + ((L & 1) ? LT_E : 0); }
__host__ __device__ constexpr int slot_cap(int k) { return k == 3 * DEPTH - 2 ? CV_TOTAL - I_FO - (CV_PRO + 7 * 84 * FILL_CAP_FF + 2 * 224 * FILL_CAP_IE + 116 * FILL_CAP_QKV)
    : (k % 3) == 1 ? (((k / 3) & 1) ? 116 * FILL_CAP_QKV : 224 * FILL_CAP_IE) : 84 * FILL_CAP_FF; }
__host__ __device__ constexpr int slot_begin_k(int k) { int b = CV_PRO; for (int j = 0; j < k; ++j) b += slot_cap(j); return b < CV_TOTAL ? b : CV_TOTAL; }
__host__ __device__ constexpr int slot_begin(int L, int s) { return slot_begin_k(3 * L + s); }
__host__ __device__ constexpr int slot_end(int L, int s) { return slot_begin_k(3 * L + s + 1); }
__host__ __device__ constexpr int cv_need(int k) { const int L = k / 3, sl = k % 3, in_ = (L & 1) ? I_QKV : I_IE;
    return cv_layer_begin(L) + (sl == 0 ? I_FI : (sl == 1 ? I_FI + I_FO + in_ : 2 * I_FI + I_FO + in_ + I_DD)); }
__host__ __device__ constexpr bool cv_schedule_ok() { for (int k = 0; k < 3 * DEPTH; ++k) if (slot_begin_k(k) < cv_need(k)) return false; return slot_begin_k(3 * DEPTH) == CV_TOTAL; }
static_assert(cv_schedule_ok(), "conversion schedule: a weight would be converted after the phase that reads it");

static_assert(MOD_ROWS == 64, "one k-row per lane");
__device__ __forceinline__ void setup_task(Frame& F, int L, int t) {
    const int cb = t / (D / MOD_ROWS), kc = t % (D / MOD_ROWS), n0 = cb * 256 + 4 * F.lane; const float* w = F.in[4] + ((size_t)L * D + kc * MOD_ROWS) * MODN + n0;
    const float c0 = F.in[1][kc * MOD_ROWS + F.lane], c1 = F.in[3][kc * MOD_ROWS + F.lane];
    const int s0v = __builtin_bit_cast(int, c0 / (1.f + expf(-c0))), s1v = __builtin_bit_cast(int, c1 / (1.f + expf(-c1)));
    f32x4 a0 = {0.f, 0.f, 0.f, 0.f}, a1 = {0.f, 0.f, 0.f, 0.f};
    for (int k = 0; k < MOD_ROWS; k += 16) { f32x4 wv[16];
#pragma unroll
        for (int j = 0; j < 16; ++j) wv[j] = __builtin_nontemporal_load((const f32x4*)(w + (size_t)(k + j) * MODN));
#pragma unroll
        for (int j = 0; j < 16; ++j) { const float s0 = __builtin_bit_cast(float, __builtin_amdgcn_readlane(s0v, k + j)), s1 = __builtin_bit_cast(float, __builtin_amdgcn_readlane(s1v, k + j)); a0 += wv[j] * s0; a1 += wv[j] * s1; } }
    if (kc == 0) { const f32x4 bb = *(const f32x4*)(F.in[5] + (size_t)L * MODN + n0); a0 += bb; a1 += bb; }
    float* pp = (float*)(F.ws + WS_MODPART) + (((size_t)L * 32 + kc) * 2) * MODN + n0;
    *(f32x4*)pp = a0; *(f32x4*)(pp + MODN) = a1;
}
__device__ __forceinline__ void mod_reduce(Frame& F, int L, int n_begin, int n_end, bool allwaves) {
    if (!allwaves && F.wave != 0) return;
    const int nq = (n_end - n_begin) >> 2, nw = allwaves ? NWAVES : 1;
    const float* pb = (const float*)(F.ws + WS_MODPART) + (size_t)L * 32 * 2 * MODN; float* mb = (float*)(F.ws + WS_MOD) + (size_t)L * 2 * MODN;
    for (int gi = (F.bid * nw + (allwaves ? F.wave : 0)) * 64 + F.lane; gi < 2 * nq; gi += F.G * nw * 64) {
        const int v = gi / nq, n = n_begin + 4 * (gi - v * nq); const float* p = pb + (size_t)v * MODN + n;
        f32x4 acc = {0.f, 0.f, 0.f, 0.f};
        for (int k0 = 0; k0 < 32; k0 += 16) { f32x4 x[16];
#pragma unroll
            for (int k = 0; k < 16; ++k) x[k] = *(const f32x4*)(p + (size_t)(k0 + k) * 2 * MODN);
#pragma unroll
            for (int k = 0; k < 16; ++k) acc += x[k]; }
        *(f32x4*)(mb + (size_t)v * MODN + n) = acc;
    }
}
struct ConvDesc { const float* W; half_t* Wt; int K, N, perm, k0, n0; };
__device__ __forceinline__ ConvDesc conv_decode(Frame& F, int g) {
    unsigned char* ws = F.ws; const int L = (g >= cv_layer_begin(1)) + (g >= cv_layer_begin(2)) + (g >= cv_layer_begin(3)); int c = g - cv_layer_begin(L); const int x = L >> 1, nin = (L & 1) ? I_QKV : I_IE;
    ConvDesc d; int item; int sub = 0;
    if (c >= I_FI + I_FO + nin + I_DD) { c -= I_FI + I_FO + nin + I_DD; sub = 1; }
    const int mi = L * 2 + sub;
    if (c < I_FI) { d.W = F.in[7] + (size_t)mi * D * NFFIN; d.Wt = (half_t*)(ws + WS_WFI) + (size_t)mi * NFFIN * D; d.K = D; d.N = NFFIN; d.perm = 1; item = c; }
    else { c -= I_FI;
      if (c < I_FO) { d.W = F.in[8] + (size_t)mi * DFF * D; d.Wt = (half_t*)(ws + WS_WFO) + (size_t)mi * D * DFF; d.K = DFF; d.N = D; d.perm = 0; item = c; }
      else { c -= I_FO;
        if (c < nin) { item = c; d.K = D; if (L & 1) { d.W = F.in[14] + (size_t)x * D * NQKV; d.Wt = (half_t*)(ws + WS_WQKV) + (size_t)x * NQKV * D; d.N = NQKV; d.perm = 2; } else { d.W = F.in[9] + (size_t)x * D * NEV; d.Wt = (half_t*)(ws + WS_WIE) + (size_t)x * NEV * D; d.N = NEV; d.perm = 0; } }
        else { item = c - nin; d.K = D; d.N = D; d.perm = 0; d.W = ((L & 1) ? F.in[15] : F.in[10]) + (size_t)x * D * D; d.Wt = (half_t*)(ws + ((L & 1) ? WS_WOO : WS_WOE)) + (size_t)x * D * D; } } }
    const int ntn = d.N >> 5; d.k0 = (item / ntn) * 64; d.n0 = (item % ntn) * 32; return d;
}
__device__ __forceinline__ void conv_range(Frame& F, int begin, int end, int j, int nidle) {
    LAS float* scr = (LAS float*)(F.lds + F.wave * 16384); const int lane = F.lane, stride = nidle * NWAVES;
    int t = begin + j * NWAVES + F.wave; if (t >= end) return;
    ConvDesc dn = conv_decode(F, t); f32x4 vn[8];
#define CV_LOAD() do { _Pragma("unroll") for (int _i = 0; _i < 8; ++_i) vn[_i] = __builtin_nontemporal_load((const f32x4*)(dn.W + (size_t)(dn.k0 + _i * 8 + (lane >> 3)) * dn.N + dn.n0 + 4 * (lane & 7))); } while (0)
    CV_LOAD();
    while (t < end) {
        const ConvDesc d = dn; f32x4 v[8];
#pragma unroll
        for (int i = 0; i < 8; ++i) v[i] = vn[i];
        const int tn = t + stride;
        if (tn < end) { dn = conv_decode(F, tn); CV_LOAD(); }
#pragma unroll
        for (int i = 0; i < 8; ++i) { LAS float* p = scr + (i * 8 + (lane >> 3)) * 33 + 4 * (lane & 7); p[0] = v[i][0]; p[1] = v[i][1]; p[2] = v[i][2]; p[3] = v[i][3]; }
        asm volatile("s_waitcnt lgkmcnt(0)" ::: "memory"); __builtin_amdgcn_wave_barrier();
#pragma unroll
        for (int i = 0; i < 4; ++i) { const int n = 8 * i + (lane >> 3), kc = 8 * (lane & 7); h8 o;
#pragma unroll
            for (int jj = 0; jj < 8; ++jj) o[jj] = (half_t)scr[(kc + jj) * 33 + n];
            const int nn = d.n0 + n, dr = d.perm == 1 ? dst_row<1>(nn) : (d.perm == 2 ? dst_row<2>(nn) : nn);
            __builtin_nontemporal_store(opround(o, (d.perm == 1 || d.K == DFF) ? DROP_FFN : DROP_MIX), (h8*)(d.Wt + (size_t)dr * d.K + d.k0 + kc)); }
        asm volatile("s_waitcnt lgkmcnt(0)" ::: "memory"); __builtin_amdgcn_wave_barrier();
        t = tn;
    }
#undef CV_LOAD
}
__device__ __forceinline__ void filler_tasks(Frame& F, int begin, int end, int total_units) {
    const int rem = total_units % F.G; int j = F.bid - rem, nidle = F.G - rem;
    if (rem == 0) { j = F.bid; nidle = F.G; }
    if (j < 0) return;
    conv_range(F, begin, end, j, nidle);
}
__device__ __forceinline__ void filler_mod(Frame& F, int L, int begin, int end, int total_units) {
    const int rem = total_units % F.G; int j = F.bid - rem, nidle = F.G - rem;
    if (rem == 0) { j = F.bid; nidle = F.G; }
    if (j < 0) return;
    for (int t = begin + j * NWAVES + F.wave; t < end; t += nidle * NWAVES) setup_task(F, L, t);
}
__device__ __forceinline__ void prologue0_phase(Frame& F) {
    unsigned char* ws = F.ws; const int gt = F.bid * NTHREADS + F.tid, nt = F.G * NTHREADS;
    { const int gw = F.bid * NWAVES + F.wave, NGW = F.G * NWAVES;
      for (int t = gw; t < (N_LAUNCH_MODE == 0 ? 1 : DEPTH) * NT_MOD; t += NGW) setup_task(F, t / NT_MOD, t % NT_MOD); }
    { float* LB = (float*)(ws + WS_LB); const float* lg = F.in[12];
      for (int i = gt; i < 2 * 1024; i += nt) { const int d = i >> 10, j = i & 1023; const float l0 = lg[(d * 2 + 0) * 1024 + j], l1 = lg[(d * 2 + 1) * 1024 + j];
          LB[(d * 2 + 0) * 1024 + j] = 0.f; LB[(d * 2 + 1) * 1024 + j] = 1.f / (1.f + expf(l0 - l1)); }
      float* RC = (float*)(ws + WS_ROPE); float* RS = RC + 128 * 32;
      for (int i = gt; i < 128 * 32; i += nt) { const int pos = i >> 5, j = i & 31; const float inv = powf(10000.0f, -(float)j / 32.0f); const float ang = (float)pos * inv; RC[i] = cosf(ang); RS[i] = sinf(ang); } }
    { h8* Hd = (h8*)(ws + WS_H); const f32x4* xs = (const f32x4*)F.in[0]; const f32x4* cs = (const f32x4*)F.in[2];
      const size_t nx = (size_t)SEQ * D / 8, nc = (size_t)NCTX * D / 8;
      for (size_t i = gt; i < nx; i += nt) Hd[i] = pack8(xs[2 * i], xs[2 * i + 1]);
      for (size_t i = gt; i < nc; i += nt) Hd[nx + i] = pack8(cs[2 * i], cs[2 * i + 1]); }
}
__device__ __forceinline__ void prologue_phase(Frame& F) {
    for (int L = 0; L < (N_LAUNCH_MODE == 0 ? 1 : DEPTH); ++L) mod_reduce(F, L, 0, MODN, true);
    conv_range(F, 0, CV_PRO, F.bid, F.G);
}

__device__ __forceinline__ void adaln_phase(Frame& F, const float* g, const float* mod_lat, const float* mod_ctx, int row_end, int nparts, int drop) {
    const int gw = F.bid * NWAVES + F.wave, NGW = F.G * NWAVES;
    half_t* H = (half_t*)(F.ws + WS_H); half_t* U = (half_t*)(F.ws + WS_U); const float* PART = (const float*)(F.ws + WS_PART);
    if (nparts > 0 && row_end > SEQ) {
        LAS float* red = (LAS float*)F.lds;
        for (int cr = F.bid; cr < NCTX; cr += F.G) {
            const int c = 4 * F.tid; half_t* hr = H + (size_t)(SEQ + cr) * D + c; const float* pr = PART + (size_t)cr * D + c;
            const h4 hh = *(const h4*)hr; f32x4 x = {(float)hh[0], (float)hh[1], (float)hh[2], (float)hh[3]};
            for (int p0 = 0; p0 < nparts; p0 += 11) { f32x4 pv[11];
#pragma unroll
                for (int p = 0; p < 11; ++p) pv[p] = (p0 + p < nparts) ? *(const f32x4*)(pr + (size_t)(p0 + p) * NCTX * D) : (f32x4){0.f, 0.f, 0.f, 0.f};
#pragma unroll
                for (int p = 0; p < 11; ++p) x += pv[p]; }
            h4 hn;
#pragma unroll
            for (int j = 0; j < 4; ++j) { hn[j] = (half_t)x[j]; x[j] = (float)hn[j]; }
            *(h4*)hr = hn;
            float ss = wave_sum(x[0] * x[0] + x[1] * x[1] + x[2] * x[2] + x[3] * x[3]);
            __syncthreads();
            if (F.lane == 0) red[F.wave] = ss;
            __syncthreads();
            ss = ((red[0] + red[1]) + (red[2] + red[3])) + ((red[4] + red[5]) + (red[6] + red[7]));
            const float rstd = rsqrtf(ss * (1.0f / D) + EPS); const float* md = mod_lat + MODN;
            const f32x4 gv = *(const f32x4*)(g + c), sh = *(const f32x4*)(md + c), sc = *(const f32x4*)(md + D + c);
            const f32x4 o = (x * rstd * gv) * (sc + 1.0f) + sh; h4 oh;
#pragma unroll
            for (int j = 0; j < 4; ++j) oh[j] = (half_t)o[j];
            *(h4*)(U + (size_t)(SEQ + cr) * D + c) = opround(oh, drop);
        }
        row_end = SEQ; nparts = 0;
    }
    h8 xn[4]; int row = gw;
    if (row < row_end) {
#pragma unroll
        for (int i = 0; i < 4; ++i) xn[i] = *(const h8*)(H + (size_t)row * D + 8 * (F.lane + 64 * i)); }
    f32x4 Gv[4][2], Sv[4][2];
#pragma unroll
    for (int i = 0; i < 4; ++i)
#pragma unroll
        for (int h = 0; h < 2; ++h) { const int c = 8 * (F.lane + 64 * i) + 4 * h; Gv[i][h] = *(const f32x4*)(g + c) * (*(const f32x4*)(mod_lat + D + c) + 1.0f); Sv[i][h] = *(const f32x4*)(mod_lat + c); }
    while (row < row_end) {
        f32x4 x[4][2];
#pragma unroll
        for (int i = 0; i < 4; ++i)
#pragma unroll
            for (int j = 0; j < 4; ++j) { x[i][0][j] = (float)xn[i][j]; x[i][1][j] = (float)xn[i][4 + j]; }
        const int nrow = row + NGW;
        if (nrow < row_end) {
#pragma unroll
            for (int i = 0; i < 4; ++i) xn[i] = *(const h8*)(H + (size_t)nrow * D + 8 * (F.lane + 64 * i)); }
        float ss = 0.f;
#pragma unroll
        for (int i = 0; i < 4; ++i)
#pragma unroll
            for (int j = 0; j < 4; ++j) ss += x[i][0][j] * x[i][0][j] + x[i][1][j] * x[i][1][j];
        ss = wave_sum(ss); const float rstd = rsqrtf(ss * (1.0f / D) + EPS);
        if (row >= SEQ) {
            const float* md = mod_lat + MODN;
#pragma unroll
            for (int i = 0; i < 4; ++i) { const int c = 8 * (F.lane + 64 * i); f32x4 o[2];
#pragma unroll
                for (int h = 0; h < 2; ++h) { const f32x4 gv = *(const f32x4*)(g + c + 4 * h), sh = *(const f32x4*)(md + c + 4 * h), sc = *(const f32x4*)(md + D + c + 4 * h);
                    o[h] = (x[i][h] * rstd * gv) * (sc + 1.0f) + sh; }
                *(h8*)(U + (size_t)row * D + c) = opround(pack8(o[0], o[1]), drop); }
        } else {
#pragma unroll
            for (int i = 0; i < 4; ++i) { const int c = 8 * (F.lane + 64 * i);
                *(h8*)(U + (size_t)row * D + c) = opround(pack8(x[i][0] * rstd * Gv[i][0] + Sv[i][0], x[i][1] * rstd * Gv[i][1] + Sv[i][1]), drop); }
        }
        row = nrow;
    }
    (void)mod_ctx;
}
__device__ __forceinline__ void final_norm_phase(Frame& F) {
    const int gw = F.bid * NWAVES + F.wave, NGW = F.G * NWAVES;
    const half_t* H = (const half_t*)(F.ws + WS_H); const float* g = F.in[17];
    for (int row = gw; row < SEQ; row += NGW) {
        f32x4 x[4][2]; float ss = 0.f;
#pragma unroll
        for (int i = 0; i < 4; ++i) { const h8 hv = *(const h8*)(H + (size_t)row * D + 8 * (F.lane + 64 * i));
#pragma unroll
            for (int j = 0; j < 4; ++j) { x[i][0][j] = (float)hv[j]; x[i][1][j] = (float)hv[4 + j]; ss += x[i][0][j] * x[i][0][j] + x[i][1][j] * x[i][1][j]; } }
        ss = wave_sum(ss); const float rstd = rsqrtf(ss * (1.0f / D) + EPS);
#pragma unroll
        for (int i = 0; i < 4; ++i) { const int c = 8 * (F.lane + 64 * i);
#pragma unroll
            for (int h = 0; h < 2; ++h) *(f32x4*)(F.out + (size_t)row * D + c + 4 * h) = x[i][h] * rstd * *(const f32x4*)(g + c + 4 * h); }
    }
}

constexpr int AT_KP = 136, AT_VP = 68;
constexpr int AT_KBYTES = 64 * AT_KP * 2, AT_VBYTES = 128 * AT_VP * 2, AT_BUF = AT_KBYTES + AT_VBYTES, AT_BIAS_OFF = 2 * AT_BUF, AT_OUT_OFF = AT_BIAS_OFF + 2048;
template <int MODE, int PV = 0>
__device__ __forceinline__ void attn_item(Frame& F, int it, const float* rpb_e, const float* sinkp) {
    const int w = F.wave, q = F.lane & 31, hh = F.lane >> 5;
    constexpr bool EVEN = MODE < 2;
    const half_t* Qb; const half_t* Kb; const half_t* VTb; half_t* Ob; int qtok, lt0 = 0, lt1 = 0;
    constexpr int qpitch = EVEN ? 1024 : 2048, kpitch = EVEN ? 1024 : 512;
    int r = 0, qc = 0, c0 = 0, r0w = 0, q0w = 0; float sink2 = 0.f;
    if (MODE == 0) { const int rg = it >> 3, h = it & 7; r = 4 * rg + (w >> 1); qc = 32 * (w & 1) + q; qtok = 64 * r + qc; c0 = min(max(qc - 8, 0), 48); r0w = min(max(r - 4, 0), 120);
        lt0 = min(max(4 * rg - 4, 0), 120); lt1 = min(max(4 * rg - 1, 0), 120) + 8;
        Qb = (const half_t*)(F.ws + WS_QA) + h * 128; Kb = (const half_t*)(F.ws + WS_KA) + h * 128; VTb = (const half_t*)(F.ws + WS_VTA) + (size_t)h * 128 * MR; Ob = (half_t*)(F.ws + WS_Y) + h * 128;
    } else if (MODE == 1) { const int h = it; qtok = SEQ + 32 * w + q;
        Qb = (const half_t*)(F.ws + WS_QA) + h * 128; Kb = (const half_t*)(F.ws + WS_KA) + h * 128; VTb = (const half_t*)(F.ws + WS_VTA) + (size_t)h * 128 * MR; Ob = (half_t*)(F.ws + WS_Y) + h * 128;
    } else if (MODE == 2) { const int nb = it >> 3, kvh = (it >> 1) & 3, gh = it & 1, hq = 4 * kvh + 2 * gh + (w >> 2); q0w = 128 * nb + 32 * (w & 3); qtok = q0w + q;
        lt0 = max(0, 2 * nb - 2); lt1 = min(128, 2 * nb + 4); sink2 = sinkp[hq] * LOG2E;
        Qb = (const half_t*)(F.ws + WS_Q) + hq * 128; Kb = (const half_t*)(F.ws + WS_K) + kvh * 128; VTb = (const half_t*)(F.ws + WS_VT) + (size_t)kvh * 128 * MR; Ob = (half_t*)(F.ws + WS_Y) + hq * 128;
    } else { const int hq = it, kvh = hq >> 2; qtok = SEQ + 32 * w + q; sink2 = sinkp[hq] * LOG2E;
        Qb = (const half_t*)(F.ws + WS_Q) + hq * 128; Kb = (const half_t*)(F.ws + WS_K) + kvh * 128; VTb = (const half_t*)(F.ws + WS_VT) + (size_t)kvh * 128 * MR; Ob = (half_t*)(F.ws + WS_Y) + hq * 128;
    }
    const int nl = lt1 - lt0, ntiles = nl + 4;
    __syncthreads();
    LAS float* bt = (LAS float*)(F.lds + AT_BIAS_OFF);
    if (MODE == 0) { const int h = it & 7; for (int i = F.tid; i < 15 * 31; i += NTHREADS) bt[i] = rpb_e[h * 15 * 31 + i] * LOG2E; }
    h8 qf[8];
#pragma unroll
    for (int ks = 0; ks < 8; ++ks) qf[ks] = *(const h8*)(Qb + (size_t)qtok * qpitch + 16 * ks + 8 * hh);
    f32x16 oacc[4];
#pragma unroll
    for (int dt = 0; dt < 4; ++dt)
#pragma unroll
        for (int i = 0; i < 16; ++i) oacc[dt][i] = 0.f;
    float m_run = -INFINITY, l_run = 0.f;
    h8 kreg[2], vreg[2];
#define AT_TOK0(ti) ((ti) < nl ? 64 * (lt0 + (ti)) : SEQ + 64 * ((ti) - nl))
#define AT_LOAD(ti) do { const int _t0 = AT_TOK0(ti); _Pragma("unroll") for (int _i = 0; _i < 2; ++_i) { const int _c = F.tid + NTHREADS * _i; \
        kreg[_i] = *(const h8*)(Kb + (size_t)(_t0 + (_c >> 4)) * kpitch + 8 * (_c & 15)); vreg[_i] = *(const h8*)(VTb + (size_t)(_c >> 3) * MR + _t0 + 8 * (_c & 7)); } } while (0)
    if (!(PV & 4)) AT_LOAD(0);
    for (int ti = 0; ti < ntiles; ++ti) {
        LAS half_t* Kl = (LAS half_t*)(F.lds + (ti & 1) * AT_BUF); LAS half_t* Vl = (LAS half_t*)(F.lds + (ti & 1) * AT_BUF + AT_KBYTES);
        if (!(PV & 4))
#pragma unroll
        for (int i = 0; i < 2; ++i) { const int c = F.tid + NTHREADS * i; *(LAS h8*)(Kl + (c >> 4) * AT_KP + 8 * (c & 15)) = kreg[i];
            LAS h4* vp = (LAS h4*)(Vl + (c >> 3) * AT_VP + 8 * (c & 7)); h4 a, b;
#pragma unroll
            for (int j = 0; j < 4; ++j) { a[j] = vreg[i][j]; b[j] = vreg[i][4 + j]; }
            vp[0] = a; vp[1] = b; }
        __syncthreads();
        if (ti + 1 < ntiles && !(PV & 4)) AT_LOAD(ti + 1);
        const bool local = ti < nl; const int kt0 = AT_TOK0(ti); bool need = true;
        if (MODE == 0 && local) { const int kr = lt0 + ti; need = (kr >= r0w) && (kr < r0w + 8); }
        if (MODE == 2 && local) need = (kt0 + 63 >= q0w - 128) && (kt0 <= q0w + 31 + 128);
        if (need) {
            f32x16 s0, s1; const f32x16 zero16 = {0.f, 0.f, 0.f, 0.f, 0.f, 0.f, 0.f, 0.f, 0.f, 0.f, 0.f, 0.f, 0.f, 0.f, 0.f, 0.f};
            { h8 a0[8], a1[8];
#pragma unroll
              for (int ks = 0; ks < 8; ++ks) a0[ks] = *(const LAS h8*)(Kl + q * AT_KP + 16 * ks + 8 * hh);
              __builtin_amdgcn_sched_barrier(0);
#pragma unroll
              for (int ks = 0; ks < 4; ++ks) s0 = __builtin_amdgcn_mfma_f32_32x32x16_f16(a0[ks], qf[ks], ks == 0 ? zero16 : s0, 0, 0, 0);
#pragma unroll
              for (int ks = 0; ks < 4; ++ks) a1[ks] = *(const LAS h8*)(Kl + (32 + q) * AT_KP + 16 * ks + 8 * hh);
              __builtin_amdgcn_sched_barrier(0);
#pragma unroll
              for (int ks = 4; ks < 8; ++ks) s0 = __builtin_amdgcn_mfma_f32_32x32x16_f16(a0[ks], qf[ks], s0, 0, 0, 0);
#pragma unroll
              for (int ks = 4; ks < 8; ++ks) a1[ks] = *(const LAS h8*)(Kl + (32 + q) * AT_KP + 16 * ks + 8 * hh);
              __builtin_amdgcn_sched_barrier(0);
#pragma unroll
              for (int ks = 0; ks < 8; ++ks) s1 = __builtin_amdgcn_mfma_f32_32x32x16_f16(a1[ks], qf[ks], ks == 0 ? zero16 : s1, 0, 0, 0); }
            if (MODE == 0 && local && !(PV & 1)) { const int bbase = (lt0 + ti - r + 7) * 31 + 15 - qc;
#pragma unroll
                for (int i = 0; i < 16; ++i) { const int k0 = (i & 3) + 8 * (i >> 2) + 4 * hh, k1 = k0 + 32;
                    const bool v0 = (k0 >= c0) && (k0 < c0 + 16), v1 = (k1 >= c0) && (k1 < c0 + 16);
                    s0[i] = v0 ? s0[i] + bt[v0 ? bbase + k0 : 0] : -INFINITY; s1[i] = v1 ? s1[i] + bt[v1 ? bbase + k1 : 0] : -INFINITY; } }
            if (MODE == 2 && local && !(PV & 1) && !((kt0 >= q0w + 31 - 128) && (kt0 + 63 <= q0w + 128))) { const int dbase = kt0 - qtok;
#pragma unroll
                for (int i = 0; i < 16; ++i) { const int d0 = dbase + (i & 3) + 8 * (i >> 2) + 4 * hh, d1 = d0 + 32;
                    s0[i] = (d0 <= 128 && d0 >= -128) ? s0[i] : -INFINITY; s1[i] = (d1 <= 128 && d1 >= -128) ? s1[i] : -INFINITY; } }
            float psum = 0.f; h8 pf[2][2];
            if (PV & 2) {
#pragma unroll
                for (int i = 0; i < 16; ++i) { pf[0][i >> 3][i & 7] = (half_t)s0[i]; pf[1][i >> 3][i & 7] = (half_t)s1[i]; }
                l_run += 1.f; m_run = 0.f;
            } else {
            float mloc = -INFINITY;
#pragma unroll
            for (int i = 0; i < 16; ++i) mloc = fmaxf(mloc, fmaxf(s0[i], s1[i]));
            mloc = fmaxf(mloc, __shfl_xor(mloc, 32));
            const float m_new = fmaxf(m_run, mloc), m_use = (m_new == -INFINITY) ? 0.f : m_new;
            const float alpha = fast_exp2(m_run - m_use); m_run = m_new;
#pragma unroll
            for (int i = 0; i < 16; ++i) { const float p0 = fast_exp2(s0[i] - m_use), p1 = fast_exp2(s1[i] - m_use); psum += p0 + p1; pf[0][i >> 3][i & 7] = (half_t)p0; pf[1][i >> 3][i & 7] = (half_t)p1; }
            l_run = l_run * alpha + psum;
            if (__any(alpha != 1.0f)) {
#pragma unroll
                for (int dt = 0; dt < 4; ++dt) oacc[dt] = oacc[dt] * alpha; }
            }
#pragma unroll
            for (int dp = 0; dp < 2; ++dp) {
                h4 va[2][4], vb[2][4];
#pragma unroll
                for (int d2 = 0; d2 < 2; ++d2)
#pragma unroll
                    for (int x = 0; x < 4; ++x) { const LAS h4* vp = (const LAS h4*)(Vl + (32 * (2 * dp + d2) + q) * AT_VP + 32 * (x >> 1) + 16 * (x & 1) + 4 * hh); va[d2][x] = vp[0]; vb[d2][x] = vp[2]; }
                __builtin_amdgcn_sched_barrier(0);
#pragma unroll
                for (int d2 = 0; d2 < 2; ++d2)
#pragma unroll
                    for (int x = 0; x < 4; ++x) { h8 a;
#pragma unroll
                        for (int j = 0; j < 4; ++j) { a[j] = va[d2][x][j]; a[4 + j] = vb[d2][x][j]; }
                        oacc[2 * dp + d2] = __builtin_amdgcn_mfma_f32_32x32x16_f16(a, pf[x >> 1][x & 1], oacc[2 * dp + d2], 0, 0, 0); }
            }
        }
    }
#undef AT_LOAD
#undef AT_TOK0
    float lt = l_run + __shfl_xor(l_run, 32);
    if (MODE >= 2) lt += fast_exp2(sink2 - m_run);
    const float inv = 1.0f / lt;
    int ln = F.lane; asm volatile("" : "+v"(ln));
    const int q2 = ln & 31, hh2 = ln >> 5;
    LAS half_t* Ot = (LAS half_t*)(F.lds + AT_OUT_OFF + w * (32 * AT_KP * 2));
#pragma unroll
    for (int dt = 0; dt < 4; ++dt)
#pragma unroll
        for (int g = 0; g < 4; ++g) { h4 o;
#pragma unroll
            for (int j = 0; j < 4; ++j) o[j] = (half_t)(oacc[dt][4 * g + j] * inv);
            *(LAS h4*)(Ot + q2 * AT_KP + 32 * dt + 8 * g + 4 * hh2) = o; }
    asm volatile("s_waitcnt lgkmcnt(0)" ::: "memory"); __builtin_amdgcn_wave_barrier();
    { const int rr = ln >> 4, cc = ln & 15; const int qbase = qtok - q;
#pragma unroll
      for (int i = 0; i < 8; ++i) { const h8 v = *(const LAS h8*)(Ot + (4 * i + rr) * AT_KP + 8 * cc); *(h8*)(Ob + (size_t)(qbase + 4 * i + rr) * D + 8 * cc) = v; } }
    asm volatile("s_waitcnt lgkmcnt(0)" ::: "memory"); __builtin_amdgcn_wave_barrier();
}
template <int MLAT, int MCTX, int PV = 0>
__device__ __forceinline__ void attn_phase(Frame& F, const float* rpb_e, const float* sinkp, bool need_ctx) {
    constexpr int NLAT = MLAT == 0 ? 256 : 512, NC = MCTX == 1 ? 8 : 16;
    for (int it = F.bid; it < NLAT; it += F.G) attn_item<MLAT, PV>(F, it, rpb_e, sinkp);
    if (need_ctx) for (int it = F.G - 1 - F.bid; it < NC; it += F.G) attn_item<MCTX, PV>(F, it, rpb_e, sinkp);
}

typedef __bf16 bf8 __attribute__((ext_vector_type(8)));
typedef __bf16 bf2 __attribute__((ext_vector_type(2)));
constexpr int H3_PT = 0, H3_RED = 4096, H3_QP = 4608, H3_QHI = 22016, H3_QLO = 39424, H3_KHI = 56832, H3_KLO = 74240, H3_VS = 91648, H3_P = 110080, H3_KPT = H3_QP, H3_OST = 23040;
constexpr int HP_D = 136, HP_S = 72;
__device__ __forceinline__ int hg_cidx(int dir, int rc) { return dir == 0 ? (rc + 4) % 132 : 131 - rc; }
__device__ __forceinline__ void hg_cumsum(Frame& F, const f32x2 (&lf)[8], int dir, f32x2 (&b)[8], f32x2& tot, f32x2& mid) {
    const int jp = F.tid & 63, part = F.tid >> 6; LAS f32x2* pt = (LAS f32x2*)(F.lds + H3_PT);
    f32x2 run = {0.f, 0.f};
    if (dir == 0) {
#pragma unroll
        for (int i = 0; i < 8; ++i) { run += lf[i]; b[i] = run; }
    } else {
#pragma unroll
        for (int i = 7; i >= 0; --i) { run += lf[i]; b[i] = run; }
    }
    pt[part * 64 + jp] = run;
    __syncthreads();
    f32x2 p[8];
#pragma unroll
    for (int i = 0; i < 8; ++i) p[i] = pt[i * 64 + jp];
    f32x2 pre = {0.f, 0.f};
#pragma unroll
    for (int i = 0; i < 8; ++i) { const bool take = dir == 0 ? (i < part) : (i > part); if (take) pre += p[i]; }
#pragma unroll
    for (int i = 0; i < 8; ++i) b[i] += pre;
    const f32x2 lo = (p[0] + p[1]) + (p[2] + p[3]), hi = (p[4] + p[5]) + (p[6] + p[7]);
    tot = lo + hi; mid = dir == 0 ? lo : hi;
}
__device__ __forceinline__ void hg_load_vs(Frame& F, int row0, int h) {
    const half_t* VTB = (const half_t*)(F.ws + WS_VTB) + (size_t)h * 128 * MR; LAS half_t* Vs = (LAS half_t*)(F.lds + H3_VS);
#pragma unroll
    for (int i = 0; i < 2; ++i) { const int c = F.tid + NTHREADS * i; *(LAS h8*)(Vs + (c >> 3) * HP_S + 8 * (c & 7)) = *(const h8*)(VTB + (size_t)(c >> 3) * MR + row0 + 8 * (c & 7)); }
}
__device__ __forceinline__ void hgrn_local_phase(Frame& F) {
    const half_t* LF = (const half_t*)(F.ws + WS_LF); half_t* US = (half_t*)(F.ws + WS_US); float* DEC = (float*)(F.ws + WS_DEC);
    LAS half_t* Vs = (LAS half_t*)(F.lds + H3_VS); LAS half_t* KpT = (LAS half_t*)(F.lds + H3_KPT);
    const int w = F.wave, fr = F.lane & 15, fq = F.lane >> 4, jp = F.tid & 63, part = F.tid >> 6;
    for (int it = F.bid; it < 132 * 8; it += F.G) {
        const int rc = it >> 3, h = it & 7, row0 = 64 * rc;
        __syncthreads();
        f32x2 lfa[2][8]; h2 kka[2][8];
#pragma unroll
        for (int d = 0; d < 2; ++d)
#pragma unroll
            for (int i = 0; i < 8; ++i) { const size_t o = (size_t)d * MR * 1024 + (size_t)(row0 + 8 * part + i) * 1024 + h * 128 + 2 * jp; { const h2 l2 = *(const h2*)(LF + o); lfa[d][i][0] = (float)l2[0]; lfa[d][i][1] = (float)l2[1]; } kka[d][i][0] = (half_t)(1.0f - fast_exp2(lfa[d][i][0] * LOG2E)); kka[d][i][1] = (half_t)(1.0f - fast_exp2(lfa[d][i][1] * LOG2E)); }
        hg_load_vs(F, row0, h);
#pragma unroll
        for (int dir = 0; dir < 2; ++dir) {
            const int cidx = hg_cidx(dir, rc);
            f32x2 b[8], tot, mid; const h2 (&kk)[8] = kka[dir];
            if (dir) __syncthreads();
            hg_cumsum(F, lfa[dir], dir, b, tot, mid);
            h8 o0, o1;
#pragma unroll
            for (int i = 0; i < 8; ++i) { o0[i] = (half_t)((float)kk[i][0] * __expf(tot[0] - b[i][0])); o1[i] = (half_t)((float)kk[i][1] * __expf(tot[1] - b[i][1])); }
            *(LAS h8*)(KpT + (2 * jp) * HP_S + 8 * part) = o0; *(LAS h8*)(KpT + (2 * jp + 1) * HP_S + 8 * part) = o1;
            if (part == 0) { f32x2 d; d[0] = __expf(tot[0]); d[1] = __expf(tot[1]); *(f32x2*)(DEC + ((size_t)(dir * 132 + cidx) * 8 + h) * 128 + 2 * jp) = d; }
            __syncthreads();
            half_t* Ub = US + ((size_t)(dir * 132 + cidx) * 8 + h) * 16384;
            h8 bv[2];
#pragma unroll
            for (int ks = 0; ks < 2; ++ks) bv[ks] = *(const LAS h8*)(Vs + (16 * w + fr) * HP_S + 32 * ks + 8 * fq);
            LAS half_t* Ost = (LAS half_t*)(F.lds + H3_OST + w * (16 * HP_D * 2));
#pragma unroll
            for (int dkt = 0; dkt < 8; ++dkt) { f32x4 acc = {0.f, 0.f, 0.f, 0.f};
#pragma unroll
                for (int ks = 0; ks < 2; ++ks) { const h8 a = *(const LAS h8*)(KpT + (16 * dkt + fr) * HP_S + 32 * ks + 8 * fq); acc = __builtin_amdgcn_mfma_f32_16x16x32_f16(a, bv[ks], acc, 0, 0, 0); }
                h4 o;
#pragma unroll
                for (int r = 0; r < 4; ++r) o[r] = (half_t)acc[r];
                *(LAS h4*)(Ost + fr * HP_D + 16 * dkt + 4 * fq) = o; }
            asm volatile("s_waitcnt lgkmcnt(0)" ::: "memory"); __builtin_amdgcn_wave_barrier();
#pragma unroll
            for (int i = 0; i < 4; ++i) { const int rr = 4 * i + (F.lane >> 4), cc = F.lane & 15; *(h8*)(Ub + (size_t)(16 * w + rr) * 128 + 8 * cc) = *(const LAS h8*)(Ost + rr * HP_D + 8 * cc); }
            asm volatile("s_waitcnt lgkmcnt(0)" ::: "memory"); __builtin_amdgcn_wave_barrier();
        }
    }
}
__device__ __forceinline__ void hgrn_scan_phase(Frame& F) {
    if (F.tid >= 256) return;
    half_t* US = (half_t*)(F.ws + WS_US); const float* DEC = (const float*)(F.ws + WS_DEC);
    for (int e = F.bid * 256 + F.tid; e < 2 * 8 * 128 * 32; e += F.G * 256) {
        const int dk4 = e & 31, dv = (e >> 5) & 127, h = (e >> 12) & 7, dir = e >> 15;
        half_t* up = US + ((size_t)(dir * 132) * 8 + h) * 16384 + dv * 128 + dk4 * 4; const float* dp = DEC + ((size_t)(dir * 132) * 8 + h) * 128 + dk4 * 4;
        f32x4 S = {0.f, 0.f, 0.f, 0.f};
        for (int c = 0; c < 132; c += 12) {
            h4 u[12]; f32x4 d[12];
#pragma unroll
            for (int i = 0; i < 12; ++i) { u[i] = *(const h4*)(up + (size_t)(c + i) * 8 * 16384); d[i] = *(const f32x4*)(dp + (size_t)(c + i) * 8 * 128); }
#pragma unroll
            for (int i = 0; i < 12; ++i) { h4 so;
#pragma unroll
                for (int r = 0; r < 4; ++r) so[r] = (half_t)S[r];
                *(h4*)(up + (size_t)(c + i) * 8 * 16384) = so;
#pragma unroll
                for (int r = 0; r < 4; ++r) S[r] = d[i][r] * S[r] + (float)u[i][r]; }
        }
    }
}
template <int HV = 0>
__device__ __forceinline__ void hgrn_out_phase(Frame& F) {
    const half_t* LF = (const half_t*)(F.ws + WS_LF); const half_t* US = (const half_t*)(F.ws + WS_US); const half_t* QB = (const half_t*)(F.ws + WS_QB);
    const half_t* GS = (const half_t*)(F.ws + WS_GS); half_t* Yo = (half_t*)(F.ws + WS_Y);
    LAS half_t* Qp = (LAS half_t*)(F.lds + H3_QP); LAS __bf16* Qhi = (LAS __bf16*)(F.lds + H3_QHI); LAS __bf16* Qlo = (LAS __bf16*)(F.lds + H3_QLO);
    LAS __bf16* Khi = (LAS __bf16*)(F.lds + H3_KHI); LAS __bf16* Klo = (LAS __bf16*)(F.lds + H3_KLO);
    LAS half_t* Vs = (LAS half_t*)(F.lds + H3_VS); LAS half_t* P = (LAS half_t*)(F.lds + H3_P); LAS float* red = (LAS float*)(F.lds + H3_RED);
    const int w = F.wave, fr = F.lane & 15, fq = F.lane >> 4, ti = w & 3, tt0 = 16 * ti, dv0 = 16 * w, jp = F.tid & 63, part = F.tid >> 6;
    for (int it = F.bid; it < 132 * 8; it += F.G) {
        const int rc = it >> 3, h = it & 7, row0 = 64 * rc;
        __syncthreads();
        h2 qq[8]; f32x2 lfa[2][8]; h2 kka[2][8];
#pragma unroll
        for (int i = 0; i < 8; ++i) { if (HV & 4) { qq[i][0] = (half_t)0.5f; qq[i][1] = (half_t)0.25f; } else qq[i] = *(const h2*)(QB + (size_t)(row0 + 8 * part + i) * 1024 + h * 128 + 2 * jp); }
#pragma unroll
        for (int d = 0; d < 2; ++d)
#pragma unroll
            for (int i = 0; i < 8; ++i) { const size_t o = (size_t)d * MR * 1024 + (size_t)(row0 + 8 * part + i) * 1024 + h * 128 + 2 * jp;
                if (HV & 4) { lfa[d][i] = (f32x2){-0.5f, -0.25f}; kka[d][i][0] = (half_t)0.5f; kka[d][i][1] = (half_t)0.25f; } else { { const h2 l2 = *(const h2*)(LF + o); lfa[d][i][0] = (float)l2[0]; lfa[d][i][1] = (float)l2[1]; } kka[d][i][0] = (half_t)(1.0f - fast_exp2(lfa[d][i][0] * LOG2E)); kka[d][i][1] = (half_t)(1.0f - fast_exp2(lfa[d][i][1] * LOG2E)); } }
        hg_load_vs(F, row0, h);
        f32x4 acc[4];
#pragma unroll
        for (int i = 0; i < 4; ++i) acc[i] = (f32x4){0.f, 0.f, 0.f, 0.f};
#pragma unroll
        for (int dir = 0; dir < 2; ++dir) {
            const int cidx = hg_cidx(dir, rc);
            f32x2 b[8], tot, mid; const h2 (&kk)[8] = kka[dir];
            h8 sfr[4];
            { const half_t* Sb = US + ((size_t)(dir * 132 + cidx) * 8 + h) * 16384;
#pragma unroll
              for (int ks = 0; ks < 4; ++ks) sfr[ks] = *(const h8*)(Sb + (size_t)(dv0 + fr) * 128 + 32 * ks + 8 * fq); }
            if (dir) __syncthreads();
            hg_cumsum(F, lfa[dir], dir, b, tot, mid);
            if (!(HV & 1))
#pragma unroll
            for (int i = 0; i < 8; ++i) { const int t = 8 * part + i; h2 qp; bf2 qh_, ql_, kh_, kl_;
#pragma unroll
                for (int c = 0; c < 2; ++c) { const float q = (float)qq[i][c], k = (float)kk[i][c], bb = b[i][c], dm = bb - mid[c];
                    qp[c] = (half_t)(q * __expf(bb));
                    const float qv = q * __expf(fminf(fmaxf(dm, -80.f), 80.f)), kv = k * __expf(fminf(fmaxf(-dm, -80.f), 80.f));
                    const __bf16 qh1 = (__bf16)qv, kh1 = (__bf16)kv; qh_[c] = qh1; kh_[c] = kh1; ql_[c] = (__bf16)(qv - (float)qh1); kl_[c] = (__bf16)(kv - (float)kh1); }
                *(LAS h2*)(Qp + t * HP_D + 2 * jp) = qp; *(LAS bf2*)(Qhi + t * HP_D + 2 * jp) = qh_; *(LAS bf2*)(Qlo + t * HP_D + 2 * jp) = ql_;
                *(LAS bf2*)(Khi + t * HP_D + 2 * jp) = kh_; *(LAS bf2*)(Klo + t * HP_D + 2 * jp) = kl_; }
            __syncthreads();
#pragma unroll
            for (int ks = 0; ks < 4; ++ks)
#pragma unroll
                for (int tt = 0; tt < 4; ++tt) { const h8 bq = *(const LAS h8*)(Qp + (16 * tt + fr) * HP_D + 32 * ks + 8 * fq);
                    if (!(HV & 2)) acc[tt] = __builtin_amdgcn_mfma_f32_16x16x32_f16(sfr[ks], bq, acc[tt], 0, 0, 0); else acc[tt] += (float)sfr[ks][0] * (float)bq[0]; }
#pragma unroll
            for (int sj = 0; sj < 2; ++sj) { const int si = 2 * (w >> 2) + sj; const bool need = dir == 0 ? (si <= ti) : (si >= ti); f32x4 pa = {0.f, 0.f, 0.f, 0.f};
                if (need && !(HV & 2)) {
#pragma unroll
                    for (int ks = 0; ks < 4; ++ks) { const int ko = 32 * ks + 8 * fq;
                        const bf8 ah = *(const LAS bf8*)(Khi + (16 * si + fr) * HP_D + ko), al = *(const LAS bf8*)(Klo + (16 * si + fr) * HP_D + ko);
                        const bf8 bh = *(const LAS bf8*)(Qhi + (tt0 + fr) * HP_D + ko), bl = *(const LAS bf8*)(Qlo + (tt0 + fr) * HP_D + ko);
                        pa = __builtin_amdgcn_mfma_f32_16x16x32_bf16(ah, bh, pa, 0, 0, 0); pa = __builtin_amdgcn_mfma_f32_16x16x32_bf16(ah, bl, pa, 0, 0, 0); pa = __builtin_amdgcn_mfma_f32_16x16x32_bf16(al, bh, pa, 0, 0, 0); } }
                h4 o;
#pragma unroll
                for (int r = 0; r < 4; ++r) { const int s_ = 16 * si + 4 * fq + r, t_ = tt0 + fr; const bool ok = dir == 0 ? (s_ <= t_) : (s_ >= t_); o[r] = (half_t)(ok ? pa[r] : 0.f); }
                *(LAS h4*)(P + (tt0 + fr) * HP_S + 16 * si + 4 * fq) = o; }
            __syncthreads();
#pragma unroll
            for (int ks = 0; ks < 2; ++ks) { const h8 a = *(const LAS h8*)(Vs + (dv0 + fr) * HP_S + 32 * ks + 8 * fq);
#pragma unroll
                for (int tt = 0; tt < 4; ++tt) { const h8 bp = *(const LAS h8*)(P + (16 * tt + fr) * HP_S + 32 * ks + 8 * fq);
                    if (!(HV & 2)) acc[tt] = __builtin_amdgcn_mfma_f32_16x16x32_f16(a, bp, acc[tt], 0, 0, 0); else acc[tt] += (float)a[0] * (float)bp[0]; } }
        }
        LAS float* red8 = (LAS float*)(F.lds + H3_PT);
#pragma unroll
        for (int tt = 0; tt < 4; ++tt) { float ss = 0.f;
#pragma unroll
            for (int r = 0; r < 4; ++r) ss += acc[tt][r] * acc[tt][r];
            ss += __shfl_xor(ss, 16); ss += __shfl_xor(ss, 32);
            if (fq == 0) red8[w * 64 + 16 * tt + fr] = ss; }
        __syncthreads();
        LAS half_t* Yt = Qp;
#pragma unroll
        for (int tt = 0; tt < 4; ++tt) { const int t = 16 * tt + fr; float ss = 0.f;
#pragma unroll
            for (int x = 0; x < 8; ++x) ss += red8[x * 64 + t];
            const float rstd = rsqrtf(ss * (1.0f / 128.0f) + EPS); h4 y;
#pragma unroll
            for (int r = 0; r < 4; ++r) y[r] = (half_t)(acc[tt][r] * rstd);
            *(LAS h4*)(Yt + t * HP_D + dv0 + 4 * fq) = y; }
        __syncthreads();
#pragma unroll
        for (int i = 0; i < 2; ++i) { const int c = F.tid + NTHREADS * i, t = c >> 4, cc = c & 15; const size_t row = (size_t)row0 + t;
            const h8 yv = *(const LAS h8*)(Yt + t * HP_D + 8 * cc), gs = *(const h8*)(GS + row * 1024 + h * 128 + 8 * cc); h8 o;
#pragma unroll
            for (int j = 0; j < 8; ++j) o[j] = (half_t)((float)yv[j] * (float)gs[j]);
            *(h8*)(Yo + row * D + 1024 + h * 128 + 8 * cc) = o; }
    }
}

constexpr int FFO_SLICE = 8, FFO_PARTS = (DFF / 64) / FFO_SLICE, MO_SLICE = 2, MO_PARTS = (D / 64) / MO_SLICE;
constexpr int PH_EVEN = 12, PH_ODD = 10, NPHASES = 2 + 2 * (PH_EVEN + PH_ODD) + 1;
struct Args { const float* in[18]; float* out; unsigned char* ws; int ph_lo, ph_hi; };

__global__ void __launch_bounds__(NTHREADS, 2) trunk_fwd(Args args) {
    extern __shared__ __attribute__((aligned(16))) unsigned char lds_raw[];
    Frame F; F.lds = (LAS unsigned char*)lds_raw; F.tid = threadIdx.x; F.lane = F.tid & 63; F.wave = __builtin_amdgcn_readfirstlane(F.tid >> 6); F.G = gridDim.x; F.bid = blockIdx.x;
#pragma unroll
    for (int i = 0; i < 18; ++i) F.in[i] = args.in[i];
    F.out = args.out; F.ws = args.ws;
    volatile LAS unsigned* xbw = (volatile LAS unsigned*)(F.lds + LDS_BYTES - 16);
    if (F.tid < 4) xbw[F.tid] = 0u;
    __syncthreads();
    XcdBarrier bar = xcd_barrier_post((unsigned*)(F.ws + WS_BAR), xbw);
    const int lo = args.ph_lo, hi = args.ph_hi; int ph = 0;
#ifndef SITE_MASK
#define SITE_MASK 0xFFFFFFFFu
#endif
#define SITE(n) (((SITE_MASK) >> (n)) & 1u)
#define PH_RUN (ph >= lo && ph < hi)
#define FRESH unsigned char* ws = F.ws; asm volatile("" : "+s"(ws)); asm volatile("" : "+v"(F.tid), "+v"(F.lane)); (void)ws
#define PH_END do { if (ph >= lo && ph + 1 < hi) xcd_barrier(bar); ++ph; } while (0)
#define MODP ((const float*)(ws + WS_MOD))
#define U ((half_t*)(ws + WS_U))
#define HID ((half_t*)(ws + WS_HID))
#define Y ((half_t*)(ws + WS_Y))

    if (PH_RUN) { FRESH; prologue0_phase(F); }
    PH_END;
    if (PH_RUN && SITE(0)) { FRESH; prologue_phase(F); }
    PH_END;

    for (int lp = 0; lp < 2; ++lp) {
#pragma unroll 1
        for (int par = 0; par < 2; ++par) {
            const int l = 2 * lp + par;
#define mod_lat (MODP + ((size_t)l * 2 + 0) * MODN)
#define mod_ctx (MODP + ((size_t)l * 2 + 1) * MODN)
#define ng (F.in[6] + (size_t)l * 3 * D)
            const bool need_ctx = l < DEPTH - 1;
            if (PH_RUN && SITE(1)) { FRESH; if (N_LAUNCH_MODE == 0 && l > 0) mod_reduce(F, l, MODN / 2, MODN, false);
                adaln_phase(F, ng, mod_lat, mod_ctx, MR, l > 0 ? FFO_PARTS : 0, DROP_FFN); }
            PH_END;
            if (PH_RUN && SITE(2)) { FRESH; pg8::Gemm g{U, (const half_t*)(ws + WS_WFI) + (size_t)(l * 2 + 0) * NFFIN * D, MR, NFFIN, D}; pg8::StaticOrder S; S.init(MR, NFFIN, D, F.G, F.bid);
                EpiSwiGLU E{HID}; pg8::gemm_phase(F.lds, g, S, E);
                filler_tasks(F, slot_begin(l, 0), slot_end(l, 0), S.nwg); }
            PH_END;
            if (PH_RUN && SITE(3)) { FRESH; pg8::Gemm g{HID, (const half_t*)(ws + WS_WFO) + (size_t)(l * 2 + 0) * D * DFF, MR, D, DFF}; pg8::StaticOrder S; S.init(SEQ, D, DFF, F.G, F.bid, FFO_SLICE);
                EpiResid E{ws, mod_lat + 2 * D, 0.5f}; pg8::gemm_phase(F.lds, g, S, E);
                if (l < DEPTH - 1 && N_LAUNCH_MODE == 0) filler_mod(F, l + 1, 0, NT_MOD / 2, S.nwg + S.nslu); }
            PH_END;
            if (PH_RUN && SITE(4)) { FRESH; if (N_LAUNCH_MODE == 0 && l < DEPTH - 1) mod_reduce(F, l + 1, 0, MODN / 2, false);
                adaln_phase(F, ng + D, mod_lat + 3 * D, mod_ctx + 3 * D, MR, FFO_PARTS, DROP_MIX); }
            PH_END;
            if (par == 0) {
                const int e = lp;
                if (PH_RUN && SITE(5)) { FRESH; pg8::Gemm g{U, (const half_t*)(ws + WS_WIE) + (size_t)e * NEV * D, MR, NEV, D}; pg8::StaticOrder S; S.init(MR, NEV, D, F.G, F.bid);
                    EpiEven E{(half_t*)(ws + WS_QA), (half_t*)(ws + WS_KA), (half_t*)(ws + WS_VTA), (half_t*)(ws + WS_QB), (half_t*)(ws + WS_VTB), (half_t*)(ws + WS_GS), (half_t*)(ws + WS_KH), (half_t*)(ws + WS_LF),
                              (const float*)(ws + WS_LB) + e * 1024, F.in[13] + e * 1024};
                    pg8::gemm_phase(F.lds, g, S, E);
                    filler_tasks(F, slot_begin(l, 1), slot_end(l, 1), S.nwg); }
                PH_END;
                if (PH_RUN && SITE(6)) { FRESH; attn_phase<0, 1>(F, F.in[11] + (size_t)e * 8 * 15 * 31, nullptr, need_ctx); hgrn_local_phase(F); }
                PH_END;
                if (PH_RUN) { FRESH; hgrn_scan_phase(F); }
                PH_END;
                if (PH_RUN && SITE(8)) { FRESH; hgrn_out_phase(F); }
                PH_END;
                if (PH_RUN && SITE(9)) { FRESH; pg8::Gemm g{Y, (const half_t*)(ws + WS_WOE) + (size_t)e * D * D, MR, D, D}; pg8::StaticOrder S; S.init(SEQ, D, D, F.G, F.bid, need_ctx ? MO_SLICE : 0);
                    EpiResid E{ws, mod_lat + 5 * D, 1.0f}; pg8::gemm_phase(F.lds, g, S, E); }
                PH_END;
            } else {
                const int o = lp;
                if (PH_RUN && SITE(10)) { FRESH; pg8::Gemm g{U, (const half_t*)(ws + WS_WQKV) + (size_t)o * NQKV * D, MR, NQKV, D}; pg8::StaticOrder S; S.init(MR, NQKV, D, F.G, F.bid);
                    EpiOdd E{(half_t*)(ws + WS_Q), (half_t*)(ws + WS_K), (half_t*)(ws + WS_VT), (const float*)(ws + WS_ROPE), (const float*)(ws + WS_ROPE) + 128 * 32};
                    pg8::gemm_phase(F.lds, g, S, E);
                    filler_tasks(F, slot_begin(l, 1), slot_end(l, 1), S.nwg); }
                PH_END;
                if (PH_RUN && SITE(11)) { FRESH; attn_phase<2, 3>(F, nullptr, F.in[16] + o * 16, need_ctx); }
                PH_END;
                if (PH_RUN && SITE(12)) { FRESH; pg8::Gemm g{Y, (const half_t*)(ws + WS_WOO) + (size_t)o * D * D, MR, D, D}; pg8::StaticOrder S; S.init(SEQ, D, D, F.G, F.bid, need_ctx ? MO_SLICE : 0);
                    EpiResid E{ws, mod_lat + 5 * D, 1.0f}; pg8::gemm_phase(F.lds, g, S, E); }
                PH_END;
            }
            if (PH_RUN && SITE(13)) { FRESH; adaln_phase(F, ng + 2 * D, mod_lat + 6 * D, mod_ctx + 6 * D, need_ctx ? MR : SEQ, MO_PARTS, DROP_FFN); }
            PH_END;
            if (PH_RUN && SITE(14)) { FRESH; pg8::Gemm g{U, (const half_t*)(ws + WS_WFI) + (size_t)(l * 2 + 1) * NFFIN * D, MR, NFFIN, D}; pg8::StaticOrder S; S.init(need_ctx ? MR : SEQ, NFFIN, D, F.G, F.bid);
                EpiSwiGLU E{HID}; pg8::gemm_phase(F.lds, g, S, E);
                filler_tasks(F, slot_begin(l, 2), slot_end(l, 2), S.nwg); }
            PH_END;
            if (PH_RUN && SITE(15)) { FRESH; pg8::Gemm g{HID, (const half_t*)(ws + WS_WFO) + (size_t)(l * 2 + 1) * D * DFF, MR, D, DFF}; pg8::StaticOrder S; S.init(SEQ, D, DFF, F.G, F.bid, need_ctx ? FFO_SLICE : 0);
                EpiResid E{ws, mod_lat + 8 * D, 0.5f}; pg8::gemm_phase(F.lds, g, S, E);
                if (l < DEPTH - 1 && N_LAUNCH_MODE == 0) filler_mod(F, l + 1, NT_MOD / 2, NT_MOD, S.nwg + S.nslu); }
            PH_END;
        }
    }
    if (PH_RUN && SITE(16)) { FRESH; final_norm_phase(F); }
    PH_END;
#undef PH_RUN
#undef PH_END
#undef MODP
#undef U
#undef HID
#undef Y
#undef mod_lat
#undef mod_ctx
#undef ng
}

extern "C" void kernel_launch(void* const* d_in, const int* in_sizes, int n_in, void* d_out, int out_size, void* d_ws, size_t ws_size, hipStream_t stream) {
    static int grid = 0;
    if (grid == 0) {
        if (n_in != 18 || out_size != SEQ * D || ws_size < WS_END) { fprintf(stderr, "kernel_launch: unexpected problem (n_in %d out %d ws %zu need %zu)\n", n_in, out_size, ws_size, (size_t)WS_END); grid = -1; return; }
        int dev = 0, cus = 0, per_cu = 0;
        if (hipGetDevice(&dev) != hipSuccess || hipDeviceGetAttribute(&cus, hipDeviceAttributeMultiprocessorCount, dev) != hipSuccess) { grid = -1; return; }
        if (hipFuncSetAttribute((const void*)trunk_fwd, hipFuncAttributeMaxDynamicSharedMemorySize, LDS_BYTES) != hipSuccess) { fprintf(stderr, "kernel_launch: hipFuncSetAttribute failed\n"); grid = -1; return; }
        if (hipOccupancyMaxActiveBlocksPerMultiprocessor(&per_cu, (const void*)trunk_fwd, NTHREADS, LDS_BYTES) != hipSuccess || per_cu < 1) { fprintf(stderr, "kernel_launch: occupancy query says %d\n", per_cu); }
        (void)hipGetLastError();
        grid = cus;
    }
    if (grid < 0) return;
    (void)hipMemsetAsync(d_ws, 0, WS_ZERO_END, stream);
    Args a{};
    for (int i = 0; i < 18; ++i) a.in[i] = (const float*)d_in[i];
    a.out = (float*)d_out; a.ws = (unsigned char*)d_ws;
#if N_LAUNCH_MODE == 0
    a.ph_lo = 0; a.ph_hi = NPHASES;
    hipLaunchKernelGGL(trunk_fwd, dim3(grid), dim3(NTHREADS), LDS_BYTES, stream, a);
#else
    for (int p = 0; p < NPHASES; ++p) { a.ph_lo = p; a.ph_hi = p + 1; hipLaunchKernelGGL(trunk_fwd, dim3(grid), dim3(NTHREADS), LDS_BYTES, stream, a); }
#endif
}
```
